# Optimizing an MI355X kernel written in HIP

```python
import math
import jax, jax.numpy as jnp
from jax import lax
import numpy as np

D_MODEL = 1024
BATCH = 8
SEQ = 4096
DEPTH = 1

FOURIER_GROUPS = 8
FOURIER_GROUP_DIM = 128
FOURIER_WIDTH = FOURIER_GROUPS * FOURIER_GROUP_DIM
ATTN_HEAD_DIM = 64
N_HEADS = D_MODEL // (2 * ATTN_HEAD_DIM)
QK_WIDTH = N_HEADS * 2 * ATTN_HEAD_DIM
V_WIDTH = N_HEADS * 2 * ATTN_HEAD_DIM
IN_WIDTH = FOURIER_WIDTH + 2 * QK_WIDTH + V_WIDTH
N_BRANCHES = 2
D_FF = ((-(-8 * D_MODEL // 3) + 255) // 256) * 256
PLE_DIM = 256
Q_BLOCK = 128
RMS_EPS = 1e-6

kernel_name = "hybrid_fnet_diffattn_encoder_block"


def rmsnorm(x, g):
    xf = x.astype(jnp.float32)
    y = xf * lax.rsqrt(jnp.mean(xf * xf, axis=-1, keepdims=True) + RMS_EPS)
    return (y * g.astype(jnp.float32)).astype(x.dtype)


def alibi_slopes(n_heads):
    return 2.0 ** (-8.0 * jnp.arange(1, n_heads + 1, dtype=jnp.float32) / n_heads)


def lambda_init_fn(layer_idx):
    return 0.8 - 0.6 * math.exp(-0.3 * layer_idx)


def fourier_mix(u):
    b, s, _ = u.shape
    ug = u.reshape(b, s, FOURIER_GROUPS, FOURIER_GROUP_DIM).astype(jnp.float32)
    f = jnp.fft.fftn(ug, axes=(1, 3), norm="ortho").real
    return f.reshape(b, s, FOURIER_WIDTH).astype(u.dtype)


def diff_attention(q, k, v, lam, slopes, subln_g, lambda_init):
    b, s = q.shape[0], q.shape[1]
    nblk = s // Q_BLOCK
    qb = q.reshape(b, nblk, Q_BLOCK, N_HEADS, 2, ATTN_HEAD_DIM).transpose(1, 0, 2, 3, 4, 5)
    kpos = jnp.arange(s, dtype=jnp.float32)
    scale = ATTN_HEAD_DIM ** -0.5

    def block(args):
        qi, i = args
        qpos = (i * Q_BLOCK).astype(jnp.float32) + jnp.arange(Q_BLOCK, dtype=jnp.float32)
        bias = -slopes[:, None, None] * jnp.abs(qpos[:, None] - kpos[None, :])[None]
        sc = jnp.einsum('bqhcd,bkhcd->bhcqk', qi, k).astype(jnp.float32) * scale
        a = jax.nn.softmax(sc + bias[None, :, None], axis=-1)
        w = a[:, :, 0] - lam.astype(jnp.float32) * a[:, :, 1]
        return jnp.einsum('bhqk,bkhe->bqhe', w.astype(v.dtype), v)

    o = lax.map(block, (qb, jnp.arange(nblk, dtype=jnp.int32)))
    o = o.transpose(1, 0, 2, 3, 4).reshape(b, s, N_HEADS, 2 * ATTN_HEAD_DIM)
    o = rmsnorm(o, subln_g) * (1.0 - lambda_init)
    return o.reshape(b, s, V_WIDTH)


def setup_inputs(seed: int = 0) -> dict:
    key = jax.random.key(seed)
    ks = jax.random.split(key, 24)
    f32 = jnp.float32

    def w(k, shape, fan_in):
        return jax.random.normal(k, shape, f32) * (fan_in ** -0.5)

    def gain(k, shape):
        return 1.0 + 0.02 * jax.random.normal(k, shape, f32)

    L = DEPTH
    return {
        "x": jax.random.normal(ks[0], (BATCH, SEQ, D_MODEL), f32),
        "p": jax.random.normal(ks[1], (DEPTH, BATCH, SEQ, PLE_DIM), f32),
        "g_mix": gain(ks[2], (L, D_MODEL)),
        "w_in": w(ks[3], (L, D_MODEL, IN_WIDTH), D_MODEL),
        "lambda_q1": 0.1 * jax.random.normal(ks[4], (L, ATTN_HEAD_DIM), f32),
        "lambda_k1": 0.1 * jax.random.normal(ks[5], (L, ATTN_HEAD_DIM), f32),
        "lambda_q2": 0.1 * jax.random.normal(ks[6], (L, ATTN_HEAD_DIM), f32),
        "lambda_k2": 0.1 * jax.random.normal(ks[7], (L, ATTN_HEAD_DIM), f32),
        "g_subln": gain(ks[8], (L, 2 * ATTN_HEAD_DIM)),
        "w_fourier_out": w(ks[9], (L, FOURIER_WIDTH, D_MODEL), FOURIER_WIDTH),
        "w_attn_out": w(ks[10], (L, V_WIDTH, D_MODEL), V_WIDTH),
        "w_branch_gate": w(ks[11], (L, D_MODEL, N_BRANCHES * D_MODEL), D_MODEL),
        "b_branch_gate": 0.02 * jax.random.normal(ks[12], (L, N_BRANCHES * D_MODEL), f32),
        "w_o": w(ks[13], (L, D_MODEL, D_MODEL), D_MODEL),
        "g_ffn": gain(ks[14], (L, D_MODEL)),
        "w_ffn_gate": w(ks[15], (L, D_MODEL, D_FF), D_MODEL),
        "w_ffn_up": w(ks[16], (L, D_MODEL, D_FF), D_MODEL),
        "w_ffn_down": w(ks[17], (L, D_FF, D_MODEL), D_FF),
        "g_ple": gain(ks[18], (L, D_MODEL)),
        "w_ple_gate": w(ks[19], (L, D_MODEL, D_MODEL), D_MODEL),
        "w_ple_proj": w(ks[20], (L, PLE_DIM, D_MODEL), PLE_DIM),
        "g_final": gain(ks[21], (D_MODEL,)),
    }


def reference(x, p, g_mix, w_in, lambda_q1, lambda_k1, lambda_q2, lambda_k2, g_subln,
              w_fourier_out, w_attn_out, w_branch_gate, b_branch_gate, w_o,
              g_ffn, w_ffn_gate, w_ffn_up, w_ffn_down, g_ple, w_ple_gate, w_ple_proj,
              g_final):
    b, s, d = x.shape
    slopes = alibi_slopes(N_HEADS)
    for i in range(DEPTH):
        lam_init = lambda_init_fn(i)
        h = rmsnorm(x, g_mix[i])
        u = h @ w_in[i]
        u_f = u[..., :FOURIER_WIDTH]
        q = u[..., FOURIER_WIDTH:FOURIER_WIDTH + QK_WIDTH].reshape(b, s, N_HEADS, 2, ATTN_HEAD_DIM)
        k = u[..., FOURIER_WIDTH + QK_WIDTH:FOURIER_WIDTH + 2 * QK_WIDTH].reshape(b, s, N_HEADS, 2, ATTN_HEAD_DIM)
        v = u[..., FOURIER_WIDTH + 2 * QK_WIDTH:].reshape(b, s, N_HEADS, 2 * ATTN_HEAD_DIM)

        y_f = fourier_mix(u_f) @ w_fourier_out[i]

        lam = (jnp.exp(jnp.sum(lambda_q1[i].astype(jnp.float32) * lambda_k1[i].astype(jnp.float32)))
               - jnp.exp(jnp.sum(lambda_q2[i].astype(jnp.float32) * lambda_k2[i].astype(jnp.float32)))
               + lam_init)
        y_a = diff_attention(q, k, v, lam, slopes, g_subln[i], lam_init) @ w_attn_out[i]

        gates = jax.nn.sigmoid(h @ w_branch_gate[i] + b_branch_gate[i]).reshape(b, s, N_BRANCHES, d)
        merged = gates[:, :, 0] * y_f + gates[:, :, 1] * y_a
        x = x + merged @ w_o[i]

        h2 = rmsnorm(x, g_ffn[i])
        x = x + (jax.nn.silu(h2 @ w_ffn_gate[i]) * (h2 @ w_ffn_up[i])) @ w_ffn_down[i]

        h3 = rmsnorm(x, g_ple[i])
        x = x + jax.nn.sigmoid(h3 @ w_ple_gate[i]) * (p[i] @ w_ple_proj[i])
    return rmsnorm(x, g_final)
```

```cpp
#include <hip/hip_runtime.h>
#include <hip/hip_cooperative_groups.h>
#include <cstdio>
#include <cstdint>
namespace cg = cooperative_groups;
namespace pg8 {
#define PG8_LAS __attribute__((address_space(3)))
typedef unsigned short bf16_t;
typedef short bf16x8 __attribute__((ext_vector_type(8)));
typedef float f32x4 __attribute__((ext_vector_type(4)));
typedef unsigned u32x4 __attribute__((ext_vector_type(4)));
constexpr int BM = 256, BK = 64, HALF = 128, HTB = HALF * BK * 2  , STAGE_BYTES = 8 * HTB, NXCD = 8, WGM = 8;

__host__ __device__ __forceinline__ int lds_byte(int r, int c) { const int st = (r >> 4) * 2 + (c >> 5), rr = r & 15, cc = c & 31, ob = rr * 64 + cc * 2; return st * 1024 + (ob ^ (((ob >> 9) & 1) << 5)); }
__host__ __device__ __forceinline__ void stage_rc(int b, int& R, int& C) { const int st = b / 1024, sb = b % 1024, swz = sb ^ (((sb >> 9) & 1) << 5); R = (st >> 1) * 16 + swz / 64; C = (st & 1) * 32 + (swz % 64) / 2; }
__host__ __device__ __forceinline__ int perm32(int rho) { const int n = rho >> 4, i = rho & 15; return 8 * (i >> 2) + 4 * n + (i & 3); }

struct Unit { int pm, pn; };
struct Gemm { const bf16_t* A; const bf16_t* Bt; int M, N, K; };

struct StaticOrder {
    int nM, nN, nwg, G, c;
    __host__ __device__ void init(int M, int N, int G_, int c_) { nM = M / BM; nN = N / BM; nwg = nM * nN; G = G_; c = c_; }
    __host__ __device__ bool next(int i, Unit& u) const {
        const long L = (long)i * G + c; if (L >= nwg) return false;
        int wgid = (int)L; { const int q = nwg / NXCD, r = nwg % NXCD, xcd = wgid % NXCD, off = wgid / NXCD; wgid = (xcd < r ? xcd * (q + 1) : r * (q + 1) + (xcd - r) * q) + off; }
        const int nig = WGM * nN, gid = wgid / nig, fm = gid * WGM, gsz = (nM - fm) < WGM ? (nM - fm) : WGM;
        u.pm = fm + ((wgid % nig) % gsz); u.pn = (wgid % nig) / gsz; return true;
    }
    __device__ __forceinline__ void a_ready(const Unit&) const {}
    __device__ __forceinline__ void done(const Unit&) const {}
};

__device__ __forceinline__ unsigned cvt_pk_bf16(float lo, float hi) { unsigned r; asm volatile("v_cvt_pk_bf16_f32 %0, %1, %2" : "=v"(r) : "v"(lo), "v"(hi)); return r; }
typedef float f32x2 __attribute__((ext_vector_type(2)));

#define EPI_LOOP(...) \
  _Pragma("unroll") for (int ai = 0; ai < 2; ++ai) _Pragma("unroll") for (int m = 0; m < 4; ++m) _Pragma("unroll") for (int bj = 0; bj < 2; ++bj) { \
     const int row = u.pm * BM + ai * HALF + wr * 64 + m * 16 + fr; const int col = u.pn * BM + bj * HALF + wc * 32 + 8 * fq; \
     f32x4 v0 = acc[ai][bj][m][0], v1 = acc[ai][bj][m][1]; __VA_ARGS__ }
__device__ __forceinline__ u32x4 pack8(f32x4 v0, f32x4 v1) { u32x4 w; w.x = cvt_pk_bf16(v0[0], v0[1]); w.y = cvt_pk_bf16(v0[2], v0[3]); w.z = cvt_pk_bf16(v1[0], v1[1]); w.w = cvt_pk_bf16(v1[2], v1[3]); return w; }
__device__ __forceinline__ float bf_lo(unsigned w) { return __uint_as_float(w << 16); }
__device__ __forceinline__ float bf_hi(unsigned w) { return __uint_as_float(w & 0xffff0000u); }
__device__ __forceinline__ void unpack8(u32x4 w, f32x4& a, f32x4& b) { a = (f32x4){bf_lo(w.x), bf_hi(w.x), bf_lo(w.y), bf_hi(w.y)}; b = (f32x4){bf_lo(w.z), bf_hi(w.z), bf_lo(w.w), bf_hi(w.w)}; }
__device__ __forceinline__ float sigm(float x) { return __builtin_amdgcn_rcpf(1.0f + __expf(-x)); }
__device__ __forceinline__ f32x4 sigm4(f32x4 x) { return (f32x4){sigm(x[0]), sigm(x[1]), sigm(x[2]), sigm(x[3])}; }
__device__ __forceinline__ float sum8sq(f32x4 a, f32x4 b) { return (a[0] * a[0] + a[1] * a[1]) + (a[2] * a[2] + a[3] * a[3]) + (b[0] * b[0] + b[1] * b[1]) + (b[2] * b[2] + b[3] * b[3]); }

struct EpiQKG {
    static constexpr bool PERM = true, AFTER_DRAIN = false;
    bf16_t* Q; bf16_t* Kb; bf16_t* G; const float* bias; float qscale;
    __device__ __forceinline__ void operator()(const f32x4 (&acc)[2][2][4][2], const Unit& u, int wr, int wc, int fr, int fq) const {
        if (u.pn < 4) { EPI_LOOP( *(u32x4*)(Q + (size_t)row * 1024 + col) = pack8(v0 * qscale, v1 * qscale); ) }
        else if (u.pn < 8) { EPI_LOOP( *(u32x4*)(Kb + (size_t)row * 1024 + (col - 1024)) = pack8(v0, v1); ) }
        else { EPI_LOOP( const int gc = col - 2048; const f32x4 b0 = *(const f32x4*)(bias + gc), b1 = *(const f32x4*)(bias + gc + 4);
                         *(u32x4*)(G + (size_t)row * 2048 + gc) = pack8(sigm4(v0 + b0), sigm4(v1 + b1)); ) }
    }
};
struct EpiZV {
    static constexpr bool PERM = true, AFTER_DRAIN = false;
    bf16_t* ZT; bf16_t* VT;
    __device__ __forceinline__ void operator()(const f32x4 (&acc)[2][2][4][2], const Unit& u, int wr, int wc, int fr, int fq) const {
        if (u.pm < 8) { EPI_LOOP( const int half = row >> 10, c = row & 1023, b = col >> 12, s = col & 4095;
                                  *(u32x4*)(ZT + ((size_t)(b * 1024 + c)) * 8192 + half * 4096 + s) = pack8(v0, v1); ) }
        else { EPI_LOOP( const int vf = row - 2048, b = col >> 12, s = col & 4095;
                         *(u32x4*)(VT + ((size_t)(b * 1024 + vf)) * 4096 + s) = pack8(v0, v1); ) }
    }
};
struct EpiY {
    static constexpr bool PERM = true, AFTER_DRAIN = false;
    bf16_t* Y;
    __device__ __forceinline__ void operator()(const f32x4 (&acc)[2][2][4][2], const Unit& u, int wr, int wc, int fr, int fq) const {
        EPI_LOOP( const int b = col >> 10, c = col & 1023; *(u32x4*)(Y + ((size_t)(b * 4096 + row)) * 1024 + c) = pack8(v0, v1); )
    }
};
struct EpiPlain {
    static constexpr bool PERM = true, AFTER_DRAIN = false;
    bf16_t* O; int ldc;
    __device__ __forceinline__ void operator()(const f32x4 (&acc)[2][2][4][2], const Unit& u, int wr, int wc, int fr, int fq) const {
        EPI_LOOP( *(u32x4*)(O + (size_t)row * ldc + col) = pack8(v0, v1); )
    }
};
struct EpiGateF {
    static constexpr bool PERM = true, AFTER_DRAIN = false;
    const bf16_t* G; float* T32;
    __device__ __forceinline__ void operator()(const f32x4 (&acc)[2][2][4][2], const Unit& u, int wr, int wc, int fr, int fq) const {
        EPI_LOOP( f32x4 g0, g1; unpack8(*(const u32x4*)(G + (size_t)row * 2048 + col), g0, g1);
                  float* t = T32 + (size_t)row * 1024 + col; *(f32x4*)t = g0 * v0; *(f32x4*)(t + 4) = g1 * v1; )
    }
};
struct EpiGateA {
    static constexpr bool PERM = true, AFTER_DRAIN = false;
    const bf16_t* G; const float* T32; bf16_t* MG;
    __device__ __forceinline__ void operator()(const f32x4 (&acc)[2][2][4][2], const Unit& u, int wr, int wc, int fr, int fq) const {
        EPI_LOOP( f32x4 g0, g1; unpack8(*(const u32x4*)(G + (size_t)row * 2048 + 1024 + col), g0, g1);
                  const float* t = T32 + (size_t)row * 1024 + col; const f32x4 t0 = *(const f32x4*)t, t1 = *(const f32x4*)(t + 4);
                  *(u32x4*)(MG + (size_t)row * 1024 + col) = pack8(t0 + g0 * v0, t1 + g1 * v1); )
    }
};
struct EpiResid {
    static constexpr bool PERM = true, AFTER_DRAIN = false;
    const float* base; float* out; bf16_t* outb; float* ss;
    __device__ __forceinline__ void operator()(const f32x4 (&acc)[2][2][4][2], const Unit& u, int wr, int wc, int fr, int fq) const {
#pragma unroll
        for (int ai = 0; ai < 2; ++ai)
#pragma unroll
            for (int m = 0; m < 4; ++m) { const int row = u.pm * BM + ai * HALF + wr * 64 + m * 16 + fr; float sq = 0.f;
#pragma unroll
                for (int bj = 0; bj < 2; ++bj) { const int col = u.pn * BM + bj * HALF + wc * 32 + 8 * fq; const size_t off = (size_t)row * 1024 + col;
                    const f32x4 x0 = *(const f32x4*)(base + off) + acc[ai][bj][m][0], x1 = *(const f32x4*)(base + off + 4) + acc[ai][bj][m][1];
                    *(f32x4*)(out + off) = x0; *(f32x4*)(out + off + 4) = x1; *(u32x4*)(outb + off) = pack8(x0, x1); sq += sum8sq(x0, x1); }
                sq += __shfl_xor(sq, 16); sq += __shfl_xor(sq, 32);
                if (fq == 0) __hip_atomic_fetch_add(ss + row, sq, __ATOMIC_RELAXED, __HIP_MEMORY_SCOPE_AGENT); }
    }
};
struct EpiSwiGLU {
    static constexpr bool PERM = true, AFTER_DRAIN = false;
    const float* ss; bf16_t* H;
    __device__ __forceinline__ void operator()(const f32x4 (&acc)[2][2][4][2], const Unit& u, int wr, int wc, int fr, int fq) const {
        EPI_LOOP( const float rs = __builtin_amdgcn_rsqf(ss[row] * (1.0f / 1024.0f) + 1e-6f); const f32x4 g = v0 * rs, up = v1 * rs;
                  const f32x4 h = g * sigm4(g) * up; typedef unsigned u32x2v __attribute__((ext_vector_type(2))); u32x2v w; w.x = cvt_pk_bf16(h[0], h[1]); w.y = cvt_pk_bf16(h[2], h[3]);
                  *(u32x2v*)(H + (size_t)row * 2816 + (col >> 1)) = w; )
    }
};
struct EpiPle {
    static constexpr bool PERM = true, AFTER_DRAIN = false;
    const float* ss2; const bf16_t* PP; float* x; float* ss3;
    __device__ __forceinline__ void operator()(const f32x4 (&acc)[2][2][4][2], const Unit& u, int wr, int wc, int fr, int fq) const {
#pragma unroll
        for (int ai = 0; ai < 2; ++ai)
#pragma unroll
            for (int m = 0; m < 4; ++m) { const int row = u.pm * BM + ai * HALF + wr * 64 + m * 16 + fr; float sq = 0.f;
                const float rs = __builtin_amdgcn_rsqf(ss2[row] * (1.0f / 1024.0f) + 1e-6f);
#pragma unroll
                for (int bj = 0; bj < 2; ++bj) { const int col = u.pn * BM + bj * HALF + wc * 32 + 8 * fq; const size_t off = (size_t)row * 1024 + col;
                    f32x4 p0, p1; unpack8(*(const u32x4*)(PP + off), p0, p1);
                    const f32x4 x0 = *(const f32x4*)(x + off) + sigm4(acc[ai][bj][m][0] * rs) * p0, x1 = *(const f32x4*)(x + off + 4) + sigm4(acc[ai][bj][m][1] * rs) * p1;
                    *(f32x4*)(x + off) = x0; *(f32x4*)(x + off + 4) = x1; sq += sum8sq(x0, x1); }
                sq += __shfl_xor(sq, 16); sq += __shfl_xor(sq, 32);
                if (fq == 0) __hip_atomic_fetch_add(ss3 + row, sq, __ATOMIC_RELAXED, __HIP_MEMORY_SCOPE_AGENT); }
    }
};
template <class Epi, class Sched, bool ALIGN_EPI = false, bool SP2 = false>
__device__ __forceinline__ void gemm_phase(PG8_LAS unsigned char* lds, const Gemm g, const Sched& S, const Epi& E) {
    const int tid = threadIdx.x, wid = __builtin_amdgcn_readfirstlane(tid >> 6), lane = tid & 63, wr = wid >> 2, wc = wid & 3, fr = lane & 15, fq = lane >> 4;
    const int K = g.K, nt = K / BK;
    unsigned voffA[2], voffB[2];
#pragma unroll
    for (int i = 0; i < 2; ++i) { int R, C; stage_rc(tid * 16 + i * 8192, R, C); const int Rb = Epi::PERM ? ((R & ~31) + perm32(R & 31)) : R;
        voffA[i] = (unsigned)(R * K + C) * 2u; voffB[i] = (unsigned)(Rb * K + C) * 2u; }
    const size_t kstep = (size_t)(BK * 2);
    const size_t hstep = (size_t)HALF * K * 2;
    const size_t tstep = 2 * hstep;
    const unsigned ldsw = (unsigned)wid * 1024u;
    const int aoff = lds_byte(wr * 64 + fr, fq * 8), boff = lds_byte(wc * 32 + fr, fq * 8);
#define PG8_SA(b, h) (((b) * 2 + (h)) * HTB)
#define PG8_SB(b, h) ((4 + (b) * 2 + (h)) * HTB)
#define PG8_STAGE(bufoff, gbase, voff) do { _Pragma("unroll") for (int _i = 0; _i < 2; ++_i) \
        __builtin_amdgcn_global_load_lds((const unsigned*)((const char*)(gbase) + (voff)[_i]), (PG8_LAS unsigned*)(lds + (bufoff) + ldsw + _i * 8192), 16, 0, 0); } while (0)
#define PG8_LDA(dst, b, h) do { _Pragma("unroll") for (int m = 0; m < 4; ++m) _Pragma("unroll") for (int k = 0; k < 2; ++k) dst[m][k] = *(const PG8_LAS bf16x8*)(lds + PG8_SA(b, h) + aoff + m * 2048 + k * 1024); } while (0)
#define PG8_LDB(dst, b, h) do { _Pragma("unroll") for (int n = 0; n < 2; ++n) _Pragma("unroll") for (int k = 0; k < 2; ++k) dst[n][k] = *(const PG8_LAS bf16x8*)(lds + PG8_SB(b, h) + boff + n * 2048 + k * 1024); } while (0)
#define PG8_MMA(ai, bj, At, Bt) do { __builtin_amdgcn_s_setprio(1); _Pragma("unroll") for (int m = 0; m < 4; ++m) _Pragma("unroll") for (int n = 0; n < 2; ++n) _Pragma("unroll") for (int k = 0; k < 2; ++k) \
        acc[ai][bj][m][n] = __builtin_amdgcn_mfma_f32_16x16x32_bf16(Bt[n][k], At[m][k], acc[ai][bj][m][n], 0, 0, 0); __builtin_amdgcn_s_setprio(0); } while (0)
#define PG8_WAIT_V(n) asm volatile("s_waitcnt vmcnt(" #n ")" ::: "memory")
#define PG8_WAIT_L(n) asm volatile("s_waitcnt lgkmcnt(" #n ")" ::: "memory")
#define PG8_BAR __builtin_amdgcn_s_barrier()
#define PG8_SCHED __builtin_amdgcn_sched_barrier(0)
    Unit cur, nxt; int ui = 0;
    if (!S.next(0, cur)) return;
    f32x4 acc[2][2][4][2];
#pragma unroll
    for (int a = 0; a < 2; ++a)
#pragma unroll
        for (int b = 0; b < 2; ++b)
#pragma unroll
            for (int m = 0; m < 4; ++m)
#pragma unroll
                for (int n = 0; n < 2; ++n) acc[a][b][m][n] = (f32x4){0.f, 0.f, 0.f, 0.f};
    bf16x8 At[4][2], B0[2][2], B1[2][2];
    const char* cA = (const char*)g.A + (size_t)cur.pm * tstep; const char* cB = (const char*)g.Bt + (size_t)cur.pn * tstep;
    S.a_ready(cur);
    if constexpr (SP2) {
        PG8_STAGE(PG8_SB(0, 0), cB, voffB); PG8_STAGE(PG8_SB(0, 1), cB + hstep, voffB); PG8_STAGE(PG8_SA(0, 0), cA, voffA); PG8_STAGE(PG8_SA(0, 1), cA + hstep, voffA);
        if (wr == 1) PG8_BAR;
        PG8_WAIT_V(2); PG8_BAR;
        PG8_STAGE(PG8_SB(1, 0), cB + kstep, voffB); PG8_STAGE(PG8_SA(1, 0), cA + kstep, voffA); PG8_STAGE(PG8_SB(1, 1), cB + hstep + kstep, voffB);
        PG8_WAIT_V(6); PG8_BAR;
    } else {
        PG8_STAGE(PG8_SB(0, 0), cB, voffB); PG8_STAGE(PG8_SA(0, 0), cA, voffA); PG8_STAGE(PG8_SB(0, 1), cB + hstep, voffB); PG8_STAGE(PG8_SA(0, 1), cA + hstep, voffA);
        if (wr == 1) PG8_BAR;
        PG8_WAIT_V(4); PG8_BAR;
        PG8_STAGE(PG8_SB(1, 0), cB + kstep, voffB); PG8_STAGE(PG8_SA(1, 0), cA + kstep, voffA); PG8_STAGE(PG8_SB(1, 1), cB + hstep + kstep, voffB);
        PG8_WAIT_V(6); PG8_BAR;
    }
    for (;;) {
        const bool has_next = S.next(ui + 1, nxt);
        const char* nA = has_next ? (const char*)g.A + (size_t)nxt.pm * tstep : cA; const char* nB = has_next ? (const char*)g.Bt + (size_t)nxt.pn * tstep : cB;
        for (int t = 0; t < nt; t += 2) {
            const bool last = (t == nt - 2);
            const char* a1 = cA + (size_t)(t + 1) * kstep;
            const char* a2 = last ? nA : cA + (size_t)(t + 2) * kstep; const char* b2 = last ? nB : cB + (size_t)(t + 2) * kstep;
            const char* a3 = a2 + kstep; const char* b3 = b2 + kstep;
            if (last && has_next) S.a_ready(nxt);
            if constexpr (SP2) {
            PG8_LDB(B0, 0, 0); PG8_LDB(B1, 0, 1); PG8_SCHED; PG8_LDA(At, 0, 0); PG8_STAGE(PG8_SA(1, 1), a1 + hstep, voffA);
            PG8_WAIT_V(8); PG8_WAIT_L(0); PG8_BAR; PG8_MMA(0, 0, At, B0); PG8_MMA(0, 1, At, B1); PG8_BAR; PG8_SCHED;
            PG8_LDA(At, 0, 1); PG8_STAGE(PG8_SB(0, 0), b2, voffB); PG8_STAGE(PG8_SB(0, 1), b2 + hstep, voffB); PG8_STAGE(PG8_SA(0, 0), a2, voffA);
            PG8_WAIT_V(8); PG8_WAIT_L(0); PG8_BAR; PG8_MMA(1, 0, At, B0); PG8_MMA(1, 1, At, B1); PG8_BAR; PG8_SCHED;
            PG8_LDB(B0, 1, 0); PG8_LDB(B1, 1, 1); PG8_SCHED; PG8_LDA(At, 1, 0); PG8_STAGE(PG8_SA(0, 1), a2 + hstep, voffA);
            PG8_WAIT_V(8); PG8_WAIT_L(0); PG8_BAR; PG8_MMA(0, 0, At, B0); PG8_MMA(0, 1, At, B1); PG8_BAR; PG8_SCHED;
            PG8_LDA(At, 1, 1); PG8_STAGE(PG8_SB(1, 0), b3, voffB); PG8_STAGE(PG8_SB(1, 1), b3 + hstep, voffB); PG8_STAGE(PG8_SA(1, 0), a3, voffA);
            PG8_WAIT_V(8); PG8_WAIT_L(0); PG8_BAR; PG8_MMA(1, 0, At, B0); PG8_MMA(1, 1, At, B1); PG8_BAR; PG8_SCHED;
            } else {
            PG8_LDB(B0, 0, 0); PG8_SCHED; PG8_LDA(At, 0, 0); PG8_STAGE(PG8_SA(1, 1), a1 + hstep, voffA);
            PG8_WAIT_L(8); PG8_BAR; PG8_WAIT_L(0); PG8_MMA(0, 0, At, B0); PG8_BAR; PG8_SCHED;
            PG8_LDB(B1, 0, 1); PG8_STAGE(PG8_SB(0, 0), b2, voffB);
            PG8_BAR; PG8_WAIT_L(0); PG8_MMA(0, 1, At, B1); PG8_BAR;
            PG8_LDA(At, 0, 1); PG8_STAGE(PG8_SA(0, 0), a2, voffA);
            PG8_BAR; PG8_WAIT_L(0); PG8_MMA(1, 0, At, B0); PG8_BAR; PG8_SCHED;
            PG8_STAGE(PG8_SB(0, 1), b2 + hstep, voffB);
            PG8_WAIT_V(6); PG8_BAR; PG8_MMA(1, 1, At, B1); PG8_BAR;
            PG8_LDB(B0, 1, 0); PG8_SCHED; PG8_LDA(At, 1, 0); PG8_STAGE(PG8_SA(0, 1), a2 + hstep, voffA);
            PG8_WAIT_L(8); PG8_BAR; PG8_WAIT_L(0); PG8_MMA(0, 0, At, B0); PG8_BAR; PG8_SCHED;
            PG8_LDB(B1, 1, 1); PG8_STAGE(PG8_SB(1, 0), b3, voffB);
            PG8_BAR; PG8_WAIT_L(0); PG8_MMA(0, 1, At, B1); PG8_BAR;
            PG8_LDA(At, 1, 1); PG8_STAGE(PG8_SA(1, 0), a3, voffA);
            PG8_BAR; PG8_WAIT_L(0); PG8_MMA(1, 0, At, B0); PG8_BAR; PG8_SCHED;
            PG8_STAGE(PG8_SB(1, 1), b3 + hstep, voffB);
            PG8_WAIT_V(6); PG8_BAR; PG8_MMA(1, 1, At, B1); PG8_BAR;
            }
        }
        if constexpr (ALIGN_EPI) { if (wr == 0) PG8_BAR; }
        if constexpr (!Epi::AFTER_DRAIN) { E(acc, cur, wr, wc, fr, fq); S.done(cur); }
        if (!has_next) break;
#pragma unroll
        for (int a = 0; a < 2; ++a)
#pragma unroll
            for (int b = 0; b < 2; ++b)
#pragma unroll
                for (int m = 0; m < 4; ++m)
#pragma unroll
                    for (int n = 0; n < 2; ++n) acc[a][b][m][n] = (f32x4){0.f, 0.f, 0.f, 0.f};
        cur = nxt; cA = nA; cB = nB; ++ui;
        if constexpr (ALIGN_EPI) { if (wr == 1) PG8_BAR; }
    }
    PG8_WAIT_V(0);
    if constexpr (!ALIGN_EPI) { if (wr == 0) PG8_BAR; }
    PG8_BAR;
    if constexpr (Epi::AFTER_DRAIN) { E.fused(acc, cur, wr, wc, fr, fq, lds, wid, lane); S.done(cur); }
#undef PG8_SA
#undef PG8_SB
#undef PG8_STAGE
#undef PG8_LDA
#undef PG8_LDB
#undef PG8_MMA
#undef PG8_WAIT_V
#undef PG8_WAIT_L
#undef PG8_BAR
#undef PG8_SCHED
}
}

#define LAS __attribute__((address_space(3)))
typedef unsigned short bf16;
typedef unsigned v4u __attribute__((ext_vector_type(4)));
typedef unsigned v2u __attribute__((ext_vector_type(2)));
typedef float f32x4 __attribute__((ext_vector_type(4)));
typedef short bf16x8 __attribute__((ext_vector_type(8)));
typedef float f32x16 __attribute__((ext_vector_type(16)));
constexpr int MTOK = 32768, DM = 1024, SEQ = 4096, NB = 8, NH = 8, DFF = 2816, PLE = 256;
constexpr size_t MiB = 1u << 20;
constexpr size_t WS_CTL = 0, CTL_ZERO_BYTES = 1 * MiB;
constexpr size_t WS_W1T = 1 * MiB, WS_W2T = 9 * MiB, WS_WFT = 15 * MiB, WS_WAT = 17 * MiB, WS_WOT = 19 * MiB, WS_WGUT = 21 * MiB, WS_WDT = 32 * MiB, WS_WPGT = 38 * MiB, WS_WPPT = 40 * MiB, WS_PB = 41 * MiB;
constexpr size_t WS_XN = 64 * MiB;
constexpr size_t WS_Q = 128 * MiB;
constexpr size_t WS_K = 192 * MiB;
constexpr size_t WS_VT = 256 * MiB;
constexpr size_t WS_ZT = 320 * MiB;
constexpr size_t WS_DM = 448 * MiB;
constexpr size_t WS_END = 512 * MiB;
constexpr int LDS_BYTES = 131072 + 512;
constexpr float LOG2E = 1.4426950408889634f;

__device__ __forceinline__ unsigned f2bf(float f) { unsigned u = __builtin_bit_cast(unsigned, f); return (u + 0x7fffu + ((u >> 16) & 1u)) >> 16; }
__device__ __forceinline__ unsigned pk2(float lo, float hi) { return f2bf(lo) | (f2bf(hi) << 16); }
__device__ __forceinline__ float wave_sum(float v) {
#pragma unroll
    for (int o = 1; o < 64; o <<= 1) v += __shfl_xor(v, o);
    return v;
}

namespace da {
constexpr int KROW = 272, VROW = 144, KT_BYTES = 64 * KROW, VT_BYTES = 128 * VROW, STG = KT_BYTES + VT_BYTES, EXROW = 33;
static_assert(4 * 128 * EXROW * 4 <= 2 * STG && 2 * STG <= 131072, "attention LDS");
__device__ __forceinline__ unsigned cvtpk(float lo, float hi) { unsigned r; asm volatile("v_cvt_pk_bf16_f32 %0, %1, %2" : "=v"(r) : "v"(lo), "v"(hi)); return r; }
__device__ __forceinline__ bf16x8 pack8f(const f32x16& p, int b) { v4u w; w.x = cvtpk(p[b], p[b + 1]); w.y = cvtpk(p[b + 2], p[b + 3]); w.z = cvtpk(p[b + 4], p[b + 5]); w.w = cvtpk(p[b + 6], p[b + 7]); return __builtin_bit_cast(bf16x8, w); }

__device__ __forceinline__ void attn_unit(LAS unsigned char* lds, int b, int h, int qb, const bf16* Q, const bf16* __restrict__ K, const bf16* __restrict__ VT, bf16* O, float lam, const float* __restrict__ gsub) {
    const int tid = threadIdx.x, lane = tid & 63, r32 = lane & 31, hi = lane >> 5; const int wid = __builtin_amdgcn_readfirstlane(tid >> 6), c = wid & 1, sub = wid >> 1;
    const int q0 = qb * 128, qrow = q0 + sub * 32 + r32, t0 = q0 >> 6;
    const float sl2 = __builtin_amdgcn_exp2f(-(float)(h + 1)) * LOG2E;
    bf16x8 qf[4];
    { const bf16* qp = Q + ((size_t)b * SEQ + qrow) * DM + h * 128 + c * 64 + hi * 8;
#pragma unroll
      for (int d0 = 0; d0 < 4; ++d0) qf[d0] = *(const bf16x8*)(qp + d0 * 16); }
    const bf16* Kg = K + (size_t)b * SEQ * DM + h * 128 + (size_t)(tid >> 4) * DM + (tid & 15) * 8;
    const bf16* Vg = VT + ((size_t)(b * NH + h) * 128 + (tid >> 3)) * SEQ + (tid & 7) * 8;
    const int kst = (tid >> 4) * KROW + (tid & 15) * 16, vst = KT_BYTES + (tid >> 3) * VROW + (tid & 7) * 16;
    const int sw = (r32 & ~12) | ((r32 & 4) << 1) | ((r32 & 8) >> 1);
    const int krd = sw * KROW + c * 128 + hi * 16, vrd = KT_BYTES + r32 * VROW + hi * 16;
    v4u pre[4];
#define DA_LOAD(t) do { const int kv0_ = (t) * 64; pre[0] = *(const v4u*)(Kg + (size_t)kv0_ * DM); pre[1] = *(const v4u*)(Kg + (size_t)(kv0_ + 32) * DM); \
                        pre[2] = *(const v4u*)(Vg + kv0_); pre[3] = *(const v4u*)(Vg + (size_t)64 * SEQ + kv0_); } while (0)
#define DA_STORE(sb) do { LAS unsigned char* s_ = lds + (sb) * STG; *(LAS v4u*)(s_ + kst) = pre[0]; *(LAS v4u*)(s_ + kst + 32 * KROW) = pre[1]; \
                          *(LAS v4u*)(s_ + vst) = pre[2]; *(LAS v4u*)(s_ + vst + 64 * VROW) = pre[3]; } while (0)
    f32x16 o[4];
#pragma unroll
    for (int i = 0; i < 4; ++i)
#pragma unroll
        for (int r = 0; r < 16; ++r) o[i][r] = 0.f;
    float mref = -INFINITY, lsum = 0.f;
    const float qposf = (float)(qrow - 8 * hi);
    DA_LOAD(t0); DA_STORE(0); __syncthreads();
    for (int j = 0; j < 64; ++j) {
        const int t = (t0 + j) & 63;
        if (j + 1 < 64) DA_LOAD((t0 + j + 1) & 63);
        const LAS unsigned char* st = lds + (j & 1) * STG;
        f32x16 p0, p1;
#pragma unroll
        for (int r = 0; r < 16; ++r) { p0[r] = 0.f; p1[r] = 0.f; }
#pragma unroll
        for (int d0 = 0; d0 < 4; ++d0) {
            const bf16x8 a0 = *(const LAS bf16x8*)(st + krd + d0 * 32), a1 = *(const LAS bf16x8*)(st + krd + 32 * KROW + d0 * 32);
            p0 = __builtin_amdgcn_mfma_f32_32x32x16_bf16(a0, qf[d0], p0, 0, 0, 0);
            p1 = __builtin_amdgcn_mfma_f32_32x32x16_bf16(a1, qf[d0], p1, 0, 0, 0);
        }
        const float dl = qposf - (float)(t * 64);
        float tm = -INFINITY;
#pragma unroll
        for (int r = 0; r < 16; ++r) { const float cr = (float)((r & 7) + 16 * (r >> 3));
            p0[r] = p0[r] - sl2 * __builtin_fabsf(dl - cr); p1[r] = p1[r] - sl2 * __builtin_fabsf(dl - (cr + 32.f));
            tm = __builtin_fmaxf(tm, __builtin_fmaxf(p0[r], p1[r])); }
        tm = __builtin_fmaxf(tm, __shfl_xor(tm, 32));
        if (__any(tm > mref + 8.f)) {
            const float mn = __builtin_fmaxf(mref, tm), al = __builtin_amdgcn_exp2f(mref - mn);
            lsum *= al; mref = mn;
#pragma unroll
            for (int i = 0; i < 4; ++i)
#pragma unroll
                for (int r = 0; r < 16; ++r) o[i][r] *= al;
        }
        float rs = 0.f;
#pragma unroll
        for (int r = 0; r < 16; ++r) { p0[r] = __builtin_amdgcn_exp2f(p0[r] - mref); p1[r] = __builtin_amdgcn_exp2f(p1[r] - mref); rs += p0[r] + p1[r]; }
        lsum += rs;
        bf16x8 pf[4]; pf[0] = pack8f(p0, 0); pf[1] = pack8f(p0, 8); pf[2] = pack8f(p1, 0); pf[3] = pack8f(p1, 8);
#pragma unroll
        for (int db = 0; db < 4; ++db)
#pragma unroll
            for (int ks = 0; ks < 4; ++ks) {
                const bf16x8 vf = *(const LAS bf16x8*)(st + vrd + db * 32 * VROW + ks * 32);
                o[db] = __builtin_amdgcn_mfma_f32_32x32x16_bf16(vf, pf[ks], o[db], 0, 0, 0);
            }
        if (j + 1 < 64) DA_STORE((j + 1) & 1);
        __syncthreads();
    }
#undef DA_LOAD
#undef DA_STORE
    lsum += __shfl_xor(lsum, 32);
    const float inv = 1.0f / lsum;
    LAS float* ex = (LAS float*)lds + sub * (128 * EXROW);
    if (c == 1) {
#pragma unroll
        for (int db = 0; db < 4; ++db)
#pragma unroll
            for (int r = 0; r < 16; ++r) ex[(32 * db + (r & 3) + 8 * (r >> 2) + 4 * hi) * EXROW + r32] = o[db][r] * inv;
    }
    __syncthreads();
    if (c == 0) {
        float ssq = 0.f;
#pragma unroll
        for (int db = 0; db < 4; ++db)
#pragma unroll
            for (int r = 0; r < 16; ++r) { const float v = o[db][r] * inv - lam * ex[(32 * db + (r & 3) + 8 * (r >> 2) + 4 * hi) * EXROW + r32]; o[db][r] = v; ssq += v * v; }
        ssq += __shfl_xor(ssq, 32);
        const float rstd = __builtin_amdgcn_rsqf(ssq * (1.0f / 128.0f) + 1e-6f) * 0.8f;
        bf16* op = O + ((size_t)b * SEQ + qrow) * DM + h * 128;
#pragma unroll
        for (int db = 0; db < 4; ++db)
#pragma unroll
            for (int rg = 0; rg < 4; ++rg) { const int d = 32 * db + 8 * rg + 4 * hi; const f32x4 g = *(const f32x4*)(gsub + d);
                v2u w; w.x = cvtpk(o[db][4 * rg] * rstd * g[0], o[db][4 * rg + 1] * rstd * g[1]); w.y = cvtpk(o[db][4 * rg + 2] * rstd * g[2], o[db][4 * rg + 3] * rstd * g[3]);
                *(v2u*)(op + d) = w; }
    }
    __syncthreads();
}
}

struct TrDesc { const float* W; int ldw, col0, K, ncols; bf16* WT; int row0, ilv; const float* ks; };
__device__ __forceinline__ void transpose_item(const TrDesc& d, LAS float* scr, int item, int lane) {
    const int nblk = d.ncols / 32, kb = item / nblk, nb = item % nblk, k0 = 64 * kb, n0 = 32 * nb;
#pragma unroll 8
    for (int i = 0; i < 32; ++i) { const int kk = 2 * i + (lane >> 5); float w = d.W[(size_t)(k0 + kk) * d.ldw + d.col0 + n0 + (lane & 31)]; if (d.ks) w *= d.ks[k0 + kk]; scr[kk * 33 + (lane & 31)] = w; }
    asm volatile("s_waitcnt lgkmcnt(0)" ::: "memory");
    const int c = lane & 7;
#pragma unroll
    for (int j = 0; j < 4; ++j) { const int n = (lane >> 3) + 8 * j; const LAS float* s = scr + (8 * c) * 33 + n;
        v4u o; o.x = pk2(s[0 * 33], s[1 * 33]); o.y = pk2(s[2 * 33], s[3 * 33]); o.z = pk2(s[4 * 33], s[5 * 33]); o.w = pk2(s[6 * 33], s[7 * 33]);
        const int nn = n0 + n; const int drow = d.ilv < 0 ? d.row0 + nn : 8 * (nn >> 2) + (nn & 3) + d.ilv;
        *(v4u*)(d.WT + (size_t)drow * d.K + k0 + 8 * c) = o; }
    asm volatile("s_waitcnt lgkmcnt(0)" ::: "memory");
}

struct Args { const float* in[22]; float* out; unsigned char* ws; };
__device__ __forceinline__ const float* kin_ptr(int i) { const __attribute__((address_space(4))) char* kp = (const __attribute__((address_space(4))) char*)__builtin_amdgcn_kernarg_segment_ptr();
    asm volatile("" : "+s"(kp)); return *(const float* const __attribute__((address_space(4)))*)(kp + 8 * i); }

__global__ void __launch_bounds__(512, 2) fwd_megakernel(Args a) {
    extern __shared__ __attribute__((aligned(16))) unsigned char lds_raw[];
    LAS unsigned char* lds = (LAS unsigned char*)lds_raw;
    cg::grid_group grid = cg::this_grid();
    const int tid = threadIdx.x, lane = tid & 63, wave = __builtin_amdgcn_readfirstlane(tid >> 6);
    const int G = gridDim.x, bid = blockIdx.x;
#define KIN(i) kin_ptr(i)
#define xin KIN(0)
#define pin KIN(1)
#define g_mix KIN(2)
#define w_in KIN(3)
#define lq1 KIN(4)
#define lk1 KIN(5)
#define lq2 KIN(6)
#define lk2 KIN(7)
#define g_subln KIN(8)
#define w_fo KIN(9)
#define w_ao KIN(10)
#define w_bg KIN(11)
#define b_bg KIN(12)
#define w_o KIN(13)
#define g_ffn KIN(14)
#define w_fg KIN(15)
#define w_fu KIN(16)
#define w_fd KIN(17)
#define g_ple KIN(18)
#define w_pg KIN(19)
#define w_pp KIN(20)
#define g_final KIN(21)
#define out ((float*)KIN(22))
#define ws ((unsigned char*)KIN(23))
#define ss1 ((float*)(ws + WS_CTL))
#define ss2 (ss1 + MTOK)
#define ss3 (ss1 + 2 * MTOK)
#define W1t ((bf16*)(ws + WS_W1T))
#define W2t ((bf16*)(ws + WS_W2T))
#define Wft ((bf16*)(ws + WS_WFT))
#define Wat ((bf16*)(ws + WS_WAT))
#define Wot ((bf16*)(ws + WS_WOT))
#define Wgut ((bf16*)(ws + WS_WGUT))
#define Wdt ((bf16*)(ws + WS_WDT))
#define Wpgt ((bf16*)(ws + WS_WPGT))
#define Wppt ((bf16*)(ws + WS_WPPT))
#define Pb ((bf16*)(ws + WS_PB))
#define XN ((bf16*)(ws + WS_XN))
#define Yb XN
#define X1b XN
#define Qb ((bf16*)(ws + WS_Q))
#define Ob Qb
#define Kb ((bf16*)(ws + WS_K))
#define MG Kb
#define VT ((bf16*)(ws + WS_VT))
#define PP VT
#define ZT ((bf16*)(ws + WS_ZT))
#define Hb ZT
#define Dm ((bf16*)(ws + WS_DM))
#define Gt ((bf16*)out)
#define T32 ((float*)(ws + WS_ZT))
    const int gw = bid * 8 + wave, NGW = G * 8, gt = bid * 512 + tid, NGT = G * 512;

    {
        LAS float* scr = (LAS float*)(lds + wave * 16384);
        constexpr int NI[12] = {512, 512, 1024, 512, 512, 512, 512, 1408, 1408, 1408, 512, 128};
        constexpr int NITEMS = 512 * 7 + 1024 + 1408 * 3 + 128;
        for (int it = gw; it < NITEMS; it += NGW) {
            int r = it, mi = 0;
#pragma unroll
            for (int q = 0; q < 11; ++q) { if (mi == q && r >= NI[q]) { r -= NI[q]; mi = q + 1; } }
            TrDesc d;
            switch (mi) {
                case 0: d = TrDesc{w_in, 4096, 1024, 1024, 1024, W1t, 0, -1, nullptr}; break;
                case 1: d = TrDesc{w_in, 4096, 2048, 1024, 1024, W1t, 1024, -1, nullptr}; break;
                case 2: d = TrDesc{w_bg, 2048, 0, 1024, 2048, W1t, 2048, -1, nullptr}; break;
                case 3: d = TrDesc{w_in, 4096, 3072, 1024, 1024, W2t, 2048, -1, nullptr}; break;
                case 4: d = TrDesc{w_fo, 1024, 0, 1024, 1024, Wft, 0, -1, nullptr}; break;
                case 5: d = TrDesc{w_ao, 1024, 0, 1024, 1024, Wat, 0, -1, nullptr}; break;
                case 6: d = TrDesc{w_o, 1024, 0, 1024, 1024, Wot, 0, -1, nullptr}; break;
                case 7: d = TrDesc{w_fg, 2816, 0, 1024, 2816, Wgut, 0, 0, g_ffn}; break;
                case 8: d = TrDesc{w_fu, 2816, 0, 1024, 2816, Wgut, 0, 4, g_ffn}; break;
                case 9: d = TrDesc{w_fd, 1024, 0, 2816, 1024, Wdt, 0, -1, nullptr}; break;
                case 10: d = TrDesc{w_pg, 1024, 0, 1024, 1024, Wpgt, 0, -1, g_ple}; break;
                default: d = TrDesc{w_pp, 1024, 0, 256, 1024, Wppt, 0, -1, nullptr}; break;
            }
            transpose_item(d, scr, r, lane);
        }
        {
            LAS float* Wl = scr;
            LAS float* T = scr + 1024;
            T[lane] = cospif((float)lane * (1.0f / 64.0f)); T[lane + 64] = cospif((float)(lane + 64) * (1.0f / 64.0f));
            for (int it = gw; it < 1024; it += NGW) {
                const int kb8 = it >> 3, g = it & 7, k0 = kb8 * 8;
                asm volatile("s_waitcnt lgkmcnt(0)" ::: "memory");
#pragma unroll
                for (int kk = 0; kk < 8; ++kk) { Wl[kk * 128 + lane] = w_in[(size_t)(k0 + kk) * 4096 + g * 128 + lane]; Wl[kk * 128 + 64 + lane] = w_in[(size_t)(k0 + kk) * 4096 + g * 128 + 64 + lane]; }
                asm volatile("s_waitcnt lgkmcnt(0)" ::: "memory");
                float ac[2][2][8];
#pragma unroll
                for (int i = 0; i < 2; ++i)
#pragma unroll
                    for (int j = 0; j < 2; ++j)
#pragma unroll
                        for (int k = 0; k < 8; ++k) ac[i][j][k] = 0.f;
                const int m0 = lane, m1 = lane + 64;
                for (int c = 0; c < 128; ++c) {
                    const int i0 = (c * m0) & 127, i1 = (c * m1) & 127;
                    const float c0 = T[i0], s0 = T[(i0 + 96) & 127], c1 = T[i1], s1 = T[(i1 + 96) & 127];
#pragma unroll
                    for (int k = 0; k < 8; ++k) { const float w = Wl[k * 128 + c]; ac[0][0][k] += w * c0; ac[0][1][k] += w * s0; ac[1][0][k] += w * c1; ac[1][1][k] += w * s1; }
                }
                const float sc = 0.08838834764831845f;
#pragma unroll
                for (int i = 0; i < 2; ++i)
#pragma unroll
                    for (int j = 0; j < 2; ++j) { const int n = j * 1024 + g * 128 + (i ? m1 : m0);
                        v4u o; o.x = pk2(ac[i][j][0] * sc, ac[i][j][1] * sc); o.y = pk2(ac[i][j][2] * sc, ac[i][j][3] * sc); o.z = pk2(ac[i][j][4] * sc, ac[i][j][5] * sc); o.w = pk2(ac[i][j][6] * sc, ac[i][j][7] * sc);
                        *(v4u*)(W2t + (size_t)n * 1024 + k0) = o; }
            }
        }
        for (int m = gw; m < MTOK; m += NGW) {
            const f32x4* xr = (const f32x4*)(xin + (size_t)m * DM) + lane; f32x4 v[4]; float s = 0.f;
#pragma unroll
            for (int j = 0; j < 4; ++j) { v[j] = xr[64 * j]; s += (v[j].x * v[j].x + v[j].y * v[j].y) + (v[j].z * v[j].z + v[j].w * v[j].w); }
            const float rstd = __builtin_amdgcn_rsqf(wave_sum(s) * (1.0f / 1024.0f) + 1e-6f);
            unsigned long long* o8 = (unsigned long long*)(XN + (size_t)m * DM) + lane;
#pragma unroll
            for (int j = 0; j < 4; ++j) { const f32x4 g = ((const f32x4*)g_mix)[lane + 64 * j];
                o8[64 * j] = (unsigned long long)pk2(v[j].x * rstd * g.x, v[j].y * rstd * g.y) | ((unsigned long long)pk2(v[j].z * rstd * g.z, v[j].w * rstd * g.w) << 32); }
        }
        for (int i = gt; i < MTOK * PLE / 8; i += NGT) { const f32x4 a0 = ((const f32x4*)pin)[2 * i], a1 = ((const f32x4*)pin)[2 * i + 1];
            v4u o; o.x = pk2(a0.x, a0.y); o.y = pk2(a0.z, a0.w); o.z = pk2(a1.x, a1.y); o.w = pk2(a1.z, a1.w); ((v4u*)Pb)[i] = o; }
        __syncthreads();
        { LAS float* T = (LAS float*)lds;
          for (int i = tid; i < 4096; i += 512) T[i] = cospif((float)i * (1.0f / 2048.0f)) * (1.0f / 64.0f);
          __syncthreads();
          for (int i = gt; i < 4096 * 1024; i += NGT) { const int k = i >> 10, ch = i & 1023, s0 = (ch * 8) & 4095; const int base = k * s0 + ((ch >= 512) ? 1024 : 0);
              float v[8];
#pragma unroll
              for (int e = 0; e < 8; ++e) v[e] = T[(base + e * k) & 4095];
              v4u o; o.x = pk2(v[0], v[1]); o.y = pk2(v[2], v[3]); o.z = pk2(v[4], v[5]); o.w = pk2(v[6], v[7]); ((v4u*)Dm)[i] = o; }
          __syncthreads(); }
    }
    grid.sync();

#ifndef NO_G1A
    { pg8::Gemm g{XN, W1t, MTOK, 4096, 1024}; pg8::StaticOrder S; S.init(MTOK, 4096, G, bid);
      pg8::EpiQKG E{Qb, Kb, Gt, b_bg, 0.125f * LOG2E};
      pg8::gemm_phase<pg8::EpiQKG, pg8::StaticOrder, true, true>(lds, g, S, E); }
#endif
#ifndef NO_G1B
    { pg8::Gemm g{W2t, XN, 3072, MTOK, 1024}; pg8::StaticOrder S; S.init(3072, MTOK, G, bid);
      pg8::EpiZV E{ZT, VT};
      pg8::gemm_phase<pg8::EpiZV, pg8::StaticOrder, true, true>(lds, g, S, E); }
#endif
    grid.sync();

#ifndef NO_G2
    { pg8::Gemm g{Dm, ZT, 4096, 8192, 8192}; pg8::StaticOrder S; S.init(4096, 8192, G, bid);
      pg8::EpiY E{Yb};
      pg8::gemm_phase<pg8::EpiY, pg8::StaticOrder, true, true>(lds, g, S, E); }
#endif
    {
        const float d1 = wave_sum(lq1[lane] * lk1[lane]), d2 = wave_sum(lq2[lane] * lk2[lane]);
        const float lam = __expf(d1) - __expf(d2) + 0.2f;
        for (int u = bid; u < 2048; u += G) { const int xcd = u & 7, w = u >> 3, bh = xcd * 8 + (w >> 5), qb = w & 31;
#ifndef NO_ATT
            da::attn_unit(lds, bh >> 3, bh & 7, qb, Qb, Kb, VT, Ob, lam, g_subln);
#endif
        }
    }
    grid.sync();

#ifndef NO_G3A
    { pg8::Gemm g{Yb, Wft, MTOK, 1024, 1024}; pg8::StaticOrder S; S.init(MTOK, 1024, G, bid);
      pg8::EpiGateF E{Gt, T32};
      pg8::gemm_phase<pg8::EpiGateF, pg8::StaticOrder, true, true>(lds, g, S, E); }
#endif
#ifndef NO_G3B
    { pg8::Gemm g{Ob, Wat, MTOK, 1024, 1024}; pg8::StaticOrder S; S.init(MTOK, 1024, G, bid);
      pg8::EpiGateA E{Gt, T32, MG};
      pg8::gemm_phase<pg8::EpiGateA, pg8::StaticOrder, true, true>(lds, g, S, E); }
#endif
    grid.sync();

#ifndef NO_G4A
    { pg8::Gemm g{MG, Wot, MTOK, 1024, 1024}; pg8::StaticOrder S; S.init(MTOK, 1024, G, bid);
      pg8::EpiResid E{xin, out, X1b, ss1};
      pg8::gemm_phase<pg8::EpiResid, pg8::StaticOrder, true, true>(lds, g, S, E); }
#endif
#ifndef NO_G4B
    { int kpp = 256; asm volatile("" : "+s"(kpp)); pg8::Gemm g{Pb, Wppt, MTOK, 1024, kpp}; pg8::StaticOrder S; S.init(MTOK, 1024, G, bid);
      pg8::EpiPlain E{PP, 1024};
      pg8::gemm_phase<pg8::EpiPlain, pg8::StaticOrder, true, true>(lds, g, S, E); }
#endif
    grid.sync();

#ifndef NO_G5
    { pg8::Gemm g{X1b, Wgut, MTOK, 2 * DFF, 1024}; pg8::StaticOrder S; S.init(MTOK, 2 * DFF, G, bid);
      pg8::EpiSwiGLU E{ss1, Hb};
      pg8::gemm_phase<pg8::EpiSwiGLU, pg8::StaticOrder, true, true>(lds, g, S, E); }
#endif
    grid.sync();

#ifndef NO_G6
    { pg8::Gemm g{Hb, Wdt, MTOK, 1024, DFF}; pg8::StaticOrder S; S.init(MTOK, 1024, G, bid);
      pg8::EpiResid E{out, out, X1b, ss2};
      pg8::gemm_phase<pg8::EpiResid, pg8::StaticOrder, true, true>(lds, g, S, E); }
#endif
    grid.sync();

#ifndef NO_G7
    { pg8::Gemm g{X1b, Wpgt, MTOK, 1024, 1024}; pg8::StaticOrder S; S.init(MTOK, 1024, G, bid);
      pg8::EpiPle E{ss2, PP, out, ss3};
      pg8::gemm_phase<pg8::EpiPle, pg8::StaticOrder, true, true>(lds, g, S, E); }
#endif
    grid.sync();

    for (int m = gw; m < MTOK; m += NGW) {
        f32x4* xr = (f32x4*)(out + (size_t)m * DM) + lane;
        const float rstd = __builtin_amdgcn_rsqf(ss3[m] * (1.0f / 1024.0f) + 1e-6f);
#pragma unroll
        for (int j = 0; j < 4; ++j) { const f32x4 g = ((const f32x4*)g_final)[lane + 64 * j]; xr[64 * j] = xr[64 * j] * rstd * g; }
    }
}

#undef xin
#undef pin
#undef g_mix
#undef w_in
#undef lq1
#undef lk1
#undef lq2
#undef lk2
#undef g_subln
#undef w_fo
#undef w_ao
#undef w_bg
#undef b_bg
#undef w_o
#undef g_ffn
#undef w_fg
#undef w_fu
#undef w_fd
#undef g_ple
#undef w_pg
#undef w_pp
#undef g_final
#undef out
#undef ws
#undef ss1
#undef ss2
#undef ss3
#undef W1t
#undef W2t
#undef Wft
#undef Wat
#undef Wot
#undef Wgut
#undef Wdt
#undef Wpgt
#undef Wppt
#undef Pb
#undef XN
#undef Yb
#undef X1b
#undef Qb
#undef Ob
#undef Kb
#undef MG
#undef VT
#undef PP
#undef ZT
#undef Hb
#undef Dm
#undef Gt
#undef T32
#undef KIN
extern "C" void kernel_launch(void* const* d_in, const int* in_sizes, int n_in, void* d_out, int out_size, void* d_ws, size_t ws_size, hipStream_t stream) {
    static int grid = 0;
    if (grid == 0) {
        if (n_in != 22 || in_sizes[0] != MTOK * DM || out_size != MTOK * DM || ws_size < WS_END) { fprintf(stderr, "kernel_launch: unexpected shapes / workspace (n_in %d, ws %zu)\n", n_in, ws_size); grid = -1; return; }
        int dev = 0, cus = 0, per_cu = 0;
        if (hipGetDevice(&dev) != hipSuccess || hipDeviceGetAttribute(&cus, hipDeviceAttributeMultiprocessorCount, dev) != hipSuccess) { grid = -1; return; }
        if (hipFuncSetAttribute((const void*)fwd_megakernel, hipFuncAttributeMaxDynamicSharedMemorySize, LDS_BYTES) != hipSuccess) { fprintf(stderr, "kernel_launch: hipFuncSetAttribute failed\n"); grid = -1; return; }
        if (hipOccupancyMaxActiveBlocksPerMultiprocessor(&per_cu, (const void*)fwd_megakernel, 512, LDS_BYTES) != hipSuccess || per_cu < 1) { fprintf(stderr, "kernel_launch: occupancy query failed (%d)\n", per_cu); (void)hipGetLastError(); per_cu = 1; }
        grid = cus * per_cu;
    }
    if (grid < 0) return;
    (void)hipMemsetAsync((char*)d_ws + WS_CTL, 0, CTL_ZERO_BYTES, stream);
    Args a{};
    for (int i = 0; i < 22; ++i) a.in[i] = (const float*)d_in[i];
    a.out = (float*)d_out; a.ws = (unsigned char*)d_ws;
    void* args[] = {&a};
    hipError_t e = hipLaunchCooperativeKernel((const void*)fwd_megakernel, dim3(grid), dim3(512), args, LDS_BYTES, stream);
    if (e != hipSuccess) fprintf(stderr, "cooperative launch failed: %s (grid %d)\n", hipGetErrorString(e), grid);
}
```

```cpp
#include <hip/hip_runtime.h>
#include <hip/hip_cooperative_groups.h>
#include <cstdio>
#include <cstdint>
namespace cg = cooperative_groups;
#ifndef PROBE_PHASE
#define PROBE_PHASE -1
#endif
#define PROBE_MULT 4
#define PH_BEGIN(k) unsigned long long t_ph0_##k = 0; if (PROBE_PHASE == (k)) t_ph0_##k = __builtin_amdgcn_s_memrealtime();
#define PH_END(k) if (PROBE_PHASE == (k)) { const unsigned long long t1_ = __builtin_amdgcn_s_memrealtime(), dt_ = t1_ - t_ph0_##k; while (__builtin_amdgcn_s_memrealtime() < t1_ + PROBE_MULT * dt_) __builtin_amdgcn_s_sleep(64); }
namespace pg8 {
#define PG8_LAS __attribute__((address_space(3)))
typedef unsigned short bf16_t;
typedef short bf16x8 __attribute__((ext_vector_type(8)));
typedef float f32x4 __attribute__((ext_vector_type(4)));
typedef unsigned u32x4 __attribute__((ext_vector_type(4)));
constexpr int BM = 256, BK = 64, HALF = 128, HTB = HALF * BK * 2  , STAGE_BYTES = 8 * HTB, NXCD = 8, WGM = 8;

__host__ __device__ __forceinline__ int lds_byte(int r, int c) { const int st = (r >> 4) * 2 + (c >> 5), rr = r & 15, cc = c & 31, ob = rr * 64 + cc * 2; return st * 1024 + (ob ^ (((ob >> 9) & 1) << 5)); }
__host__ __device__ __forceinline__ void stage_rc(int b, int& R, int& C) { const int st = b / 1024, sb = b % 1024, swz = sb ^ (((sb >> 9) & 1) << 5); R = (st >> 1) * 16 + swz / 64; C = (st & 1) * 32 + (swz % 64) / 2; }
__host__ __device__ __forceinline__ int perm32(int rho) { const int n = rho >> 4, i = rho & 15; return 8 * (i >> 2) + 4 * n + (i & 3); }

struct Unit { int pm, pn; };
struct Gemm { const bf16_t* A; const bf16_t* Bt; int M, N, K; };

struct StaticOrder {
    int nM, nN, nwg, G, c;
    __host__ __device__ void init(int M, int N, int G_, int c_) { nM = M / BM; nN = N / BM; nwg = nM * nN; G = G_; c = c_; }
    __host__ __device__ bool next(int i, Unit& u) const {
        const long L = (long)i * G + c; if (L >= nwg) return false;
        int wgid = (int)L; { const int q = nwg / NXCD, r = nwg % NXCD, xcd = wgid % NXCD, off = wgid / NXCD; wgid = (xcd < r ? xcd * (q + 1) : r * (q + 1) + (xcd - r) * q) + off; }
        const int nig = WGM * nN, gid = wgid / nig, fm = gid * WGM, gsz = (nM - fm) < WGM ? (nM - fm) : WGM;
        u.pm = fm + ((wgid % nig) % gsz); u.pn = (wgid % nig) / gsz; return true;
    }
    __device__ __forceinline__ void a_ready(const Unit&) const {}
    __device__ __forceinline__ void done(const Unit&) const {}
};

__device__ __forceinline__ unsigned cvt_pk_bf16(float lo, float hi) { unsigned r; asm volatile("v_cvt_pk_bf16_f32 %0, %1, %2" : "=v"(r) : "v"(lo), "v"(hi)); return r; }
typedef float f32x2 __attribute__((ext_vector_type(2)));

#define EPI_LOOP(...) \
  _Pragma("unroll") for (int ai = 0; ai < 2; ++ai) _Pragma("unroll") for (int m = 0; m < 4; ++m) _Pragma("unroll") for (int bj = 0; bj < 2; ++bj) { \
     const int row = u.pm * BM + ai * HALF + wr * 64 + m * 16 + fr; const int col = u.pn * BM + bj * HALF + wc * 32 + 8 * fq; \
     f32x4 v0 = acc[ai][bj][m][0], v1 = acc[ai][bj][m][1]; __VA_ARGS__ }
__device__ __forceinline__ u32x4 pack8(f32x4 v0, f32x4 v1) { u32x4 w; w.x = cvt_pk_bf16(v0[0], v0[1]); w.y = cvt_pk_bf16(v0[2], v0[3]); w.z = cvt_pk_bf16(v1[0], v1[1]); w.w = cvt_pk_bf16(v1[2], v1[3]); return w; }
__device__ __forceinline__ float bf_lo(unsigned w) { return __uint_as_float(w << 16); }
__device__ __forceinline__ float bf_hi(unsigned w) { return __uint_as_float(w & 0xffff0000u); }
__device__ __forceinline__ void unpack8(u32x4 w, f32x4& a, f32x4& b) { a = (f32x4){bf_lo(w.x), bf_hi(w.x), bf_lo(w.y), bf_hi(w.y)}; b = (f32x4){bf_lo(w.z), bf_hi(w.z), bf_lo(w.w), bf_hi(w.w)}; }
__device__ __forceinline__ float sigm(float x) { return __builtin_amdgcn_rcpf(1.0f + __expf(-x)); }
__device__ __forceinline__ f32x4 sigm4(f32x4 x) { return (f32x4){sigm(x[0]), sigm(x[1]), sigm(x[2]), sigm(x[3])}; }
__device__ __forceinline__ float sum8sq(f32x4 a, f32x4 b) { return (a[0] * a[0] + a[1] * a[1]) + (a[2] * a[2] + a[3] * a[3]) + (b[0] * b[0] + b[1] * b[1]) + (b[2] * b[2] + b[3] * b[3]); }

struct EpiQKG {
    static constexpr bool PERM = true, AFTER_DRAIN = false;
    bf16_t* Q; bf16_t* Kb; bf16_t* G; const float* bias; float qscale;
    __device__ __forceinline__ void operator()(const f32x4 (&acc)[2][2][4][2], const Unit& u, int wr, int wc, int fr, int fq) const {
        if (u.pn < 4) { EPI_LOOP( v0 = v0 * qscale; v1 = v1 * qscale; *(u32x4*)(Q + (size_t)row * 1024 + col) = pack8(v0, v1);
                                  float sq = sum8sq(v0, v1); sq += __shfl_xor(sq, 16); sq += __shfl_xor(sq, 32);
                                  int rr = row; asm volatile("" : "+v"(rr)); if (fq == 0) __hip_atomic_fetch_add((float*)((char*)Q - (70ll << 20)) + (size_t)(col >> 6) * 32768 + rr, sq, __ATOMIC_RELAXED, __HIP_MEMORY_SCOPE_AGENT); __builtin_amdgcn_sched_barrier(0); ) }
        else if (u.pn < 8) { EPI_LOOP( *(u32x4*)(Kb + (size_t)row * 1024 + (col - 1024)) = pack8(v0, v1);
                                  float sq = sum8sq(v0, v1); sq += __shfl_xor(sq, 16); sq += __shfl_xor(sq, 32);
                                  int rr = row; asm volatile("" : "+v"(rr)); if (fq == 0) __hip_atomic_fetch_add((float*)((char*)Q - (68ll << 20)) + (size_t)((col - 1024) >> 6) * 32768 + rr, sq, __ATOMIC_RELAXED, __HIP_MEMORY_SCOPE_AGENT); __builtin_amdgcn_sched_barrier(0); ) }
        else { EPI_LOOP( const int gc = col - 2048; const f32x4 b0 = *(const f32x4*)(bias + gc), b1 = *(const f32x4*)(bias + gc + 4);
                         __builtin_nontemporal_store(pack8(sigm4(v0 + b0), sigm4(v1 + b1)), (u32x4*)(G + (size_t)row * 2048 + gc)); ) }
    }
};
struct EpiZ4 {
    static constexpr bool PERM = true, AFTER_DRAIN = false;
    bf16_t* Z4;
    __device__ __forceinline__ void operator()(const f32x4 (&acc)[2][2][4][2], const Unit& u, int wr, int wc, int fr, int fq) const {
        EPI_LOOP( int part, c; if (row < 520) { const int g_ = row / 65; part = 0; c = g_ * 80 + (row - g_ * 65); } else { const int r_ = row - 520, g_ = r_ / 63; part = 1; c = g_ * 80 + (r_ - g_ * 63) + 1; }
                  const int b = col >> 12, s2 = (col >> 6) & 63, s1 = col & 63;
                  *(u32x4*)(Z4 + (((size_t)(b * 640 + c) * 64 + s2) * 128 + part * 64 + s1)) = pack8(v0, v1); )
    }
};
struct EpiVT {
    static constexpr bool PERM = true, AFTER_DRAIN = false;
    bf16_t* VT;
    __device__ __forceinline__ void operator()(const f32x4 (&acc)[2][2][4][2], const Unit& u, int wr, int wc, int fr, int fq) const {
        EPI_LOOP( const int b = col >> 12, s = col & 4095; *(u32x4*)(VT + ((size_t)(b * 1024 + row)) * 4096 + s) = pack8(v0, v1); )
    }
};
struct EpiG {
    static constexpr bool PERM = true, AFTER_DRAIN = false;
    const float* TW; bf16_t* Ga; bf16_t* Gb;
    __device__ __forceinline__ void operator()(const f32x4 (&acc)[2][2][4][2], const Unit& u, int wr, int wc, int fr, int fq) const {
#pragma unroll
        for (int a = 0; a < 2; ++a)
#pragma unroll
            for (int bj = 0; bj < 2; ++bj) {
                const int k1 = 32 * wr + 16 * a + fr, n = u.pn * BM + bj * HALF + wc * 32 + 8 * fq, s2 = n & 63, q_ = n >> 6, b = q_ / 640, c = q_ - b * 640;
                const f32x4 re0 = acc[0][bj][2 * a][0], re1 = acc[0][bj][2 * a][1], im0 = acc[0][bj][2 * a + 1][0], im1 = acc[0][bj][2 * a + 1][1];
                const f32x4* tw = (const f32x4*)(TW + (size_t)(k1 * 64 + s2) * 2);
                const f32x4 t0 = tw[0], t1 = tw[1], t2 = tw[2], t3 = tw[3];
                const f32x4 tr0 = {t0[0], t0[2], t1[0], t1[2]}, ti0 = {t0[1], t0[3], t1[1], t1[3]}, tr1 = {t2[0], t2[2], t3[0], t3[2]}, ti1 = {t2[1], t2[3], t3[1], t3[3]};
                bf16_t* base = (b < 4 ? Ga : Gb) + (((size_t)((b & 3) * 64 + k1) * 640 + c) * 128 + s2);
                *(u32x4*)(base) = pack8(re0 * tr0 - im0 * ti0, re1 * tr1 - im1 * ti1);
                *(u32x4*)(base + 64) = pack8(re0 * ti0 + im0 * tr0, re1 * ti1 + im1 * tr1);
            }
    }
};
struct EpiY3 {
    static constexpr bool PERM = true, AFTER_DRAIN = false;
    bf16_t* Y; int b0;
    __device__ __forceinline__ void operator()(const f32x4 (&acc)[2][2][4][2], const Unit& u, int wr, int wc, int fr, int fq) const {
        if (wr == 0) {
#pragma unroll
            for (int m = 0; m < 4; ++m)
#pragma unroll
                for (int bj = 0; bj < 2; ++bj) { const int k2 = 16 * m + fr, n = u.pn * BM + bj * HALF + wc * 32 + 8 * fq, t_ = n / 640, cp = n - t_ * 640, k1 = t_ & 63, bl = t_ >> 6, g = cp / 80, m0 = cp - g * 80;
                    const int k = k1 + 64 * k2, b = b0 + bl;
                    const u32x4 w = pack8(acc[0][bj][m][0], acc[0][bj][m][1]);
                    bf16_t* yrow = Y + ((size_t)(b * 4096 + k)) * 1024 + g * 128;
                    if (m0 < 64) {
                        *(u32x4*)(yrow + m0) = w;
                        bf16_t* ymir = Y + ((size_t)(b * 4096 + ((4096 - k) & 4095))) * 1024 + g * 128 + 128 - m0;
                        const unsigned ww[4] = {w.x, w.y, w.z, w.w};
#pragma unroll
                        for (int e = 0; e < 8; ++e) { const bf16_t v = (bf16_t)((e & 1) ? (ww[e >> 1] >> 16) : (ww[e >> 1] & 0xffffu)); if (e > 0 || m0 > 0) ymir[-e] = v; }
                    } else if (m0 == 64) yrow[64] = (bf16_t)(w.x & 0xffffu);
                }
        }
    }
};
struct EpiPlain {
    static constexpr bool PERM = true, AFTER_DRAIN = false;
    bf16_t* O; int ldc;
    __device__ __forceinline__ void operator()(const f32x4 (&acc)[2][2][4][2], const Unit& u, int wr, int wc, int fr, int fq) const {
        EPI_LOOP( __builtin_nontemporal_store(pack8(v0, v1), (u32x4*)(O + (size_t)row * ldc + col)); )
    }
};
struct EpiGateF {
    static constexpr bool PERM = true, AFTER_DRAIN = false;
    const bf16_t* G; bf16_t* T32;
    __device__ __forceinline__ void operator()(const f32x4 (&acc)[2][2][4][2], const Unit& u, int wr, int wc, int fr, int fq) const {
        EPI_LOOP( f32x4 g0, g1; unpack8(*(const u32x4*)(G + (size_t)row * 2048 + col), g0, g1);
                  *(u32x4*)(T32 + (size_t)row * 1024 + col) = pack8(g0 * v0, g1 * v1); )
    }
};
struct EpiGateA {
    static constexpr bool PERM = true, AFTER_DRAIN = false;
    const bf16_t* G; const bf16_t* T32; bf16_t* MG;
    __device__ __forceinline__ void operator()(const f32x4 (&acc)[2][2][4][2], const Unit& u, int wr, int wc, int fr, int fq) const {
        EPI_LOOP( f32x4 g0, g1; unpack8(*(const u32x4*)(G + (size_t)row * 2048 + 1024 + col), g0, g1);
                  f32x4 t0, t1; unpack8(*(const u32x4*)(T32 + (size_t)row * 1024 + col), t0, t1);
                  *(u32x4*)(MG + (size_t)row * 1024 + col) = pack8(t0 + g0 * v0, t1 + g1 * v1); )
    }
};
template <bool BASE_BF16> struct EpiResid {
    static constexpr bool PERM = true, AFTER_DRAIN = false;
    const void* base; bf16_t* outb; float* ss;
    __device__ __forceinline__ void operator()(const f32x4 (&acc)[2][2][4][2], const Unit& u, int wr, int wc, int fr, int fq) const {
#pragma unroll
        for (int ai = 0; ai < 2; ++ai)
#pragma unroll
            for (int m = 0; m < 4; ++m) { const int row = u.pm * BM + ai * HALF + wr * 64 + m * 16 + fr; float sq = 0.f;
#pragma unroll
                for (int bj = 0; bj < 2; ++bj) { const int col = u.pn * BM + bj * HALF + wc * 32 + 8 * fq; const size_t off = (size_t)row * 1024 + col;
                    f32x4 b0, b1;
                    if (BASE_BF16) unpack8(*(const u32x4*)((const bf16_t*)base + off), b0, b1); else { b0 = *(const f32x4*)((const float*)base + off); b1 = *(const f32x4*)((const float*)base + off + 4); }
                    const f32x4 x0 = b0 + acc[ai][bj][m][0], x1 = b1 + acc[ai][bj][m][1];
                    *(u32x4*)(outb + off) = pack8(x0, x1); sq += sum8sq(x0, x1); }
                sq += __shfl_xor(sq, 16); sq += __shfl_xor(sq, 32);
                if (fq == 0) __hip_atomic_fetch_add(ss + row, sq, __ATOMIC_RELAXED, __HIP_MEMORY_SCOPE_AGENT); }
    }
};
struct EpiSwiGLU {
    static constexpr bool PERM = true, AFTER_DRAIN = false;
    const float* ss; bf16_t* H;
    __device__ __forceinline__ void operator()(const f32x4 (&acc)[2][2][4][2], const Unit& u, int wr, int wc, int fr, int fq) const {
#pragma unroll
        for (int ai = 0; ai < 2; ++ai)
#pragma unroll
            for (int m = 0; m < 4; ++m) { const int row = u.pm * BM + ai * HALF + wr * 64 + m * 16 + fr, f0 = u.pn * HALF + wc * 32 + 8 * fq;
                const float rs = __builtin_amdgcn_rsqf(ss[row] * (1.0f / 1024.0f) + 1e-6f);
                const f32x4 g0 = acc[ai][0][m][0] * rs, g1 = acc[ai][0][m][1] * rs, u0 = acc[ai][1][m][0] * rs, u1 = acc[ai][1][m][1] * rs;
                *(u32x4*)(H + (size_t)row * 2816 + f0) = pack8(g0 * sigm4(g0) * u0, g1 * sigm4(g1) * u1); }
    }
};
struct EpiPle {
    static constexpr bool PERM = true, AFTER_DRAIN = false;
    const float* ss2; const bf16_t* PP; const bf16_t* x; bf16_t* X3b; float* ss3;
    __device__ __forceinline__ void operator()(const f32x4 (&acc)[2][2][4][2], const Unit& u, int wr, int wc, int fr, int fq) const {
#pragma unroll
        for (int ai = 0; ai < 2; ++ai)
#pragma unroll
            for (int m = 0; m < 4; ++m) { const int row = u.pm * BM + ai * HALF + wr * 64 + m * 16 + fr; float sq = 0.f;
                const float rs = __builtin_amdgcn_rsqf(ss2[row] * (1.0f / 1024.0f) + 1e-6f);
#pragma unroll
                for (int bj = 0; bj < 2; ++bj) { const int col = u.pn * BM + bj * HALF + wc * 32 + 8 * fq; const size_t off = (size_t)row * 1024 + col;
                    f32x4 p0, p1; unpack8(*(const u32x4*)(PP + off), p0, p1);
                    f32x4 xb0, xb1; unpack8(*(const u32x4*)(x + off), xb0, xb1);
                    const f32x4 x0 = xb0 + sigm4(acc[ai][bj][m][0] * rs) * p0, x1 = xb1 + sigm4(acc[ai][bj][m][1] * rs) * p1;
                    *(u32x4*)(X3b + off) = pack8(x0, x1); sq += sum8sq(x0, x1); }
                sq += __shfl_xor(sq, 16); sq += __shfl_xor(sq, 32);
                if (fq == 0) __hip_atomic_fetch_add(ss3 + row, sq, __ATOMIC_RELAXED, __HIP_MEMORY_SCOPE_AGENT); }
    }
};
template <class Epi, class Sched, bool ALIGN_EPI = false, bool SP2 = false>
__device__ __forceinline__ void gemm_phase(PG8_LAS unsigned char* lds, const Gemm g, const Sched& S, const Epi& E) {
    int tid_ = threadIdx.x; asm volatile("" : "+v"(tid_));
    const int tid = tid_, wid = __builtin_amdgcn_readfirstlane(tid >> 6), lane = tid & 63, wr = wid >> 2, wc = wid & 3, fr = lane & 15, fq = lane >> 4;
    const int K = g.K, nt = K / BK;
    unsigned voffA[2], voffB[2];
#pragma unroll
    for (int i = 0; i < 2; ++i) { int R, C; stage_rc(tid * 16 + i * 8192, R, C); const int Rb = Epi::PERM ? ((R & ~31) + perm32(R & 31)) : R;
        voffA[i] = (unsigned)(R * K + C) * 2u; voffB[i] = (unsigned)(Rb * K + C) * 2u; }
    const size_t kstep = (size_t)(BK * 2);
    const size_t hstep = (size_t)HALF * K * 2;
    const size_t tstep = 2 * hstep;
    const unsigned ldsw = (unsigned)wid * 1024u;
    const int aoff = lds_byte(wr * 64 + fr, fq * 8), boff = lds_byte(wc * 32 + fr, fq * 8);
#define PG8_SA(b, h) (((b) * 2 + (h)) * HTB)
#define PG8_SB(b, h) ((4 + (b) * 2 + (h)) * HTB)
#define PG8_STAGE(bufoff, gbase, voff) do { _Pragma("unroll") for (int _i = 0; _i < 2; ++_i) \
        __builtin_amdgcn_global_load_lds((const unsigned*)((const char*)(gbase) + (voff)[_i]), (PG8_LAS unsigned*)(lds + (bufoff) + ldsw + _i * 8192), 16, 0, 0); } while (0)
#define PG8_LDA(dst, b, h) do { _Pragma("unroll") for (int m = 0; m < 4; ++m) _Pragma("unroll") for (int k = 0; k < 2; ++k) dst[m][k] = *(const PG8_LAS bf16x8*)(lds + PG8_SA(b, h) + aoff + m * 2048 + k * 1024); } while (0)
#define PG8_LDB(dst, b, h) do { _Pragma("unroll") for (int n = 0; n < 2; ++n) _Pragma("unroll") for (int k = 0; k < 2; ++k) dst[n][k] = *(const PG8_LAS bf16x8*)(lds + PG8_SB(b, h) + boff + n * 2048 + k * 1024); } while (0)
#define PG8_MMA(ai, bj, At, Bt) do { __builtin_amdgcn_s_setprio(1); _Pragma("unroll") for (int m = 0; m < 4; ++m) _Pragma("unroll") for (int n = 0; n < 2; ++n) _Pragma("unroll") for (int k = 0; k < 2; ++k) \
        acc[ai][bj][m][n] = __builtin_amdgcn_mfma_f32_16x16x32_bf16(Bt[n][k], At[m][k], acc[ai][bj][m][n], 0, 0, 0); __builtin_amdgcn_s_setprio(0); } while (0)
#define PG8_WAIT_V(n) asm volatile("s_waitcnt vmcnt(" #n ")" ::: "memory")
#define PG8_WAIT_L(n) asm volatile("s_waitcnt lgkmcnt(" #n ")" ::: "memory")
#define PG8_BAR __builtin_amdgcn_s_barrier()
#define PG8_SCHED __builtin_amdgcn_sched_barrier(0)
    Unit cur, nxt; int ui = 0;
    if (!S.next(0, cur)) return;
    f32x4 acc[2][2][4][2];
#pragma unroll
    for (int a = 0; a < 2; ++a)
#pragma unroll
        for (int b = 0; b < 2; ++b)
#pragma unroll
            for (int m = 0; m < 4; ++m)
#pragma unroll
                for (int n = 0; n < 2; ++n) acc[a][b][m][n] = (f32x4){0.f, 0.f, 0.f, 0.f};
    bf16x8 At[4][2], B0[2][2], B1[2][2];
    const char* cA = (const char*)g.A + (size_t)cur.pm * tstep; const char* cB = (const char*)g.Bt + (size_t)cur.pn * tstep;
    S.a_ready(cur);
    if constexpr (SP2) {
        PG8_STAGE(PG8_SB(0, 0), cB, voffB); PG8_STAGE(PG8_SB(0, 1), cB + hstep, voffB); PG8_STAGE(PG8_SA(0, 0), cA, voffA); PG8_STAGE(PG8_SA(0, 1), cA + hstep, voffA);
        if (wr == 1) PG8_BAR;
        PG8_WAIT_V(2); PG8_BAR;
        PG8_STAGE(PG8_SB(1, 0), cB + kstep, voffB); PG8_STAGE(PG8_SA(1, 0), cA + kstep, voffA); PG8_STAGE(PG8_SB(1, 1), cB + hstep + kstep, voffB);
        PG8_WAIT_V(6); PG8_BAR;
    } else {
        PG8_STAGE(PG8_SB(0, 0), cB, voffB); PG8_STAGE(PG8_SA(0, 0), cA, voffA); PG8_STAGE(PG8_SB(0, 1), cB + hstep, voffB); PG8_STAGE(PG8_SA(0, 1), cA + hstep, voffA);
        if (wr == 1) PG8_BAR;
        PG8_WAIT_V(4); PG8_BAR;
        PG8_STAGE(PG8_SB(1, 0), cB + kstep, voffB); PG8_STAGE(PG8_SA(1, 0), cA + kstep, voffA); PG8_STAGE(PG8_SB(1, 1), cB + hstep + kstep, voffB);
        PG8_WAIT_V(6); PG8_BAR;
    }
    for (;;) {
        const bool has_next = S.next(ui + 1, nxt);
        const char* nA = has_next ? (const char*)g.A + (size_t)nxt.pm * tstep : cA; const char* nB = has_next ? (const char*)g.Bt + (size_t)nxt.pn * tstep : cB;
        for (int t = 0; t < nt; t += 2) {
            const bool last = (t == nt - 2);
            const char* a1 = cA + (size_t)(t + 1) * kstep;
            const char* a2 = last ? nA : cA + (size_t)(t + 2) * kstep; const char* b2 = last ? nB : cB + (size_t)(t + 2) * kstep;
            const char* a3 = a2 + kstep; const char* b3 = b2 + kstep;
            if (last && has_next) S.a_ready(nxt);
            if constexpr (SP2) {
            PG8_LDB(B0, 0, 0); PG8_LDB(B1, 0, 1); PG8_SCHED; PG8_LDA(At, 0, 0); PG8_STAGE(PG8_SA(1, 1), a1 + hstep, voffA);
            PG8_WAIT_V(8); PG8_WAIT_L(0); PG8_BAR; PG8_MMA(0, 0, At, B0); PG8_MMA(0, 1, At, B1); PG8_BAR; PG8_SCHED;
            PG8_LDA(At, 0, 1); PG8_STAGE(PG8_SB(0, 0), b2, voffB); PG8_STAGE(PG8_SB(0, 1), b2 + hstep, voffB); PG8_STAGE(PG8_SA(0, 0), a2, voffA);
            PG8_WAIT_V(8); PG8_WAIT_L(0); PG8_BAR; PG8_MMA(1, 0, At, B0); PG8_MMA(1, 1, At, B1); PG8_BAR; PG8_SCHED;
            PG8_LDB(B0, 1, 0); PG8_LDB(B1, 1, 1); PG8_SCHED; PG8_LDA(At, 1, 0); PG8_STAGE(PG8_SA(0, 1), a2 + hstep, voffA);
            PG8_WAIT_V(8); PG8_WAIT_L(0); PG8_BAR; PG8_MMA(0, 0, At, B0); PG8_MMA(0, 1, At, B1); PG8_BAR; PG8_SCHED;
            PG8_LDA(At, 1, 1); PG8_STAGE(PG8_SB(1, 0), b3, voffB); PG8_STAGE(PG8_SB(1, 1), b3 + hstep, voffB); PG8_STAGE(PG8_SA(1, 0), a3, voffA);
            PG8_WAIT_V(8); PG8_WAIT_L(0); PG8_BAR; PG8_MMA(1, 0, At, B0); PG8_MMA(1, 1, At, B1); PG8_BAR; PG8_SCHED;
            } else {
            PG8_LDB(B0, 0, 0); PG8_SCHED; PG8_LDA(At, 0, 0); PG8_STAGE(PG8_SA(1, 1), a1 + hstep, voffA);
            PG8_WAIT_L(8); PG8_BAR; PG8_WAIT_L(0); PG8_MMA(0, 0, At, B0); PG8_BAR; PG8_SCHED;
            PG8_LDB(B1, 0, 1); PG8_STAGE(PG8_SB(0, 0), b2, voffB);
            PG8_BAR; PG8_WAIT_L(0); PG8_MMA(0, 1, At, B1); PG8_BAR;
            PG8_LDA(At, 0, 1); PG8_STAGE(PG8_SA(0, 0), a2, voffA);
            PG8_BAR; PG8_WAIT_L(0); PG8_MMA(1, 0, At, B0); PG8_BAR; PG8_SCHED;
            PG8_STAGE(PG8_SB(0, 1), b2 + hstep, voffB);
            PG8_WAIT_V(6); PG8_BAR; PG8_MMA(1, 1, At, B1); PG8_BAR;
            PG8_LDB(B0, 1, 0); PG8_SCHED; PG8_LDA(At, 1, 0); PG8_STAGE(PG8_SA(0, 1), a2 + hstep, voffA);
            PG8_WAIT_L(8); PG8_BAR; PG8_WAIT_L(0); PG8_MMA(0, 0, At, B0); PG8_BAR; PG8_SCHED;
            PG8_LDB(B1, 1, 1); PG8_STAGE(PG8_SB(1, 0), b3, voffB);
            PG8_BAR; PG8_WAIT_L(0); PG8_MMA(0, 1, At, B1); PG8_BAR;
            PG8_LDA(At, 1, 1); PG8_STAGE(PG8_SA(1, 0), a3, voffA);
            PG8_BAR; PG8_WAIT_L(0); PG8_MMA(1, 0, At, B0); PG8_BAR; PG8_SCHED;
            PG8_STAGE(PG8_SB(1, 1), b3 + hstep, voffB);
            PG8_WAIT_V(6); PG8_BAR; PG8_MMA(1, 1, At, B1); PG8_BAR;
            }
        }
        if constexpr (ALIGN_EPI) { if (wr == 0) PG8_BAR; }
        if constexpr (!Epi::AFTER_DRAIN) { E(acc, cur, wr, wc, fr, fq); S.done(cur); }
        if (!has_next) break;
#pragma unroll
        for (int a = 0; a < 2; ++a)
#pragma unroll
            for (int b = 0; b < 2; ++b)
#pragma unroll
                for (int m = 0; m < 4; ++m)
#pragma unroll
                    for (int n = 0; n < 2; ++n) acc[a][b][m][n] = (f32x4){0.f, 0.f, 0.f, 0.f};
        cur = nxt; cA = nA; cB = nB; ++ui;
        if constexpr (ALIGN_EPI) { if (wr == 1) PG8_BAR; }
    }
    PG8_WAIT_V(0);
    if constexpr (!ALIGN_EPI) { if (wr == 0) PG8_BAR; }
    PG8_BAR;
    if constexpr (Epi::AFTER_DRAIN) { E.fused(acc, cur, wr, wc, fr, fq, lds, wid, lane); S.done(cur); }
#undef PG8_SA
#undef PG8_SB
#undef PG8_STAGE
#undef PG8_LDA
#undef PG8_LDB
#undef PG8_MMA
#undef PG8_WAIT_V
#undef PG8_WAIT_L
#undef PG8_BAR
#undef PG8_SCHED
}
}

#define LAS __attribute__((address_space(3)))
typedef unsigned short bf16;
typedef unsigned v4u __attribute__((ext_vector_type(4)));
typedef unsigned v2u __attribute__((ext_vector_type(2)));
typedef float f32x4 __attribute__((ext_vector_type(4)));
typedef short bf16x8 __attribute__((ext_vector_type(8)));
typedef float f32x16 __attribute__((ext_vector_type(16)));
constexpr int MTOK = 32768, DM = 1024, SEQ = 4096, NB = 8, NH = 8, DFF = 2816, PLE = 256;
constexpr size_t MiB = 1u << 20;
constexpr size_t WS_CTL = 0, CTL_ZERO_BYTES = 1 * MiB;
constexpr size_t WS_W1T = 1 * MiB, WS_W2T = 9 * MiB, WS_WFT = 15 * MiB, WS_WAT = 17 * MiB, WS_WOT = 19 * MiB, WS_WGUT = 21 * MiB, WS_WDT = 32 * MiB, WS_WPGT = 38 * MiB, WS_WPPT = 40 * MiB, WS_PB = 41 * MiB;
constexpr size_t WS_QN2 = 58 * MiB, WS_KN2 = 60 * MiB, NRM_ZERO_BYTES = 4 * MiB;
constexpr size_t WS_XN = 64 * MiB;
constexpr size_t WS_Q = 128 * MiB; static_assert(WS_Q - WS_QN2 == (70ull << 20) && WS_Q - WS_KN2 == (68ull << 20), "EpiQKG derives the norm arrays from Q");
constexpr size_t WS_K = 192 * MiB;
constexpr size_t WS_VT = 256 * MiB;
constexpr size_t WS_ZT = 320 * MiB;
constexpr size_t WS_DM = 448 * MiB;
constexpr size_t WS_F1 = 57 * MiB, WS_F3 = 57 * MiB + 65536, WS_TW = 57 * MiB + 131072; static_assert(WS_PB + (size_t)MTOK * PLE * 2 <= WS_F1 && WS_TW + 32768 <= WS_QN2, "constants sit between Pb and the norm arrays");
constexpr size_t WS_T32 = 384 * MiB;
constexpr size_t WS_END = 512 * MiB;
constexpr int LDS_BYTES = 131072 + 512;
constexpr int LDS_XB_OFF = 131072 + 256;
constexpr size_t WS_XBAR = 512 * 1024;
constexpr float LOG2E = 1.4426950408889634f;

__device__ __forceinline__ unsigned f2bf(float f) { unsigned u = __builtin_bit_cast(unsigned, f); return (u + 0x7fffu + ((u >> 16) & 1u)) >> 16; }
__device__ __forceinline__ unsigned pk2(float lo, float hi) { return f2bf(lo) | (f2bf(hi) << 16); }
__device__ __forceinline__ float wave_sum(float v) {
#pragma unroll
    for (int o = 1; o < 64; o <<= 1) v += __shfl_xor(v, o);
    return v;
}


typedef __attribute__((address_space(1))) unsigned gu32;
#define XB_TMO      128
#define XB_XCNT(j)  (256  + 64 * (j))
#define XB_XSUB(j)  (1280 + 64 * (j))
#define XB_XGEN(j)  (2304 + 64 * (j))
#define XB_TOP      3328
#define XB_TOPGEN   3392
#define XCD_BAR_WORDS 3456
#define XB_SPIN_CAP (1u << 18)

__device__ __forceinline__ unsigned xb_ld(unsigned* p)              { return __hip_atomic_load(p, __ATOMIC_RELAXED, __HIP_MEMORY_SCOPE_AGENT); }
__device__ __forceinline__ unsigned xb_add(unsigned* p, unsigned v) { return __hip_atomic_fetch_add(p, v, __ATOMIC_RELAXED, __HIP_MEMORY_SCOPE_AGENT); }
__device__ __forceinline__ unsigned xb_xcc_id() { return (unsigned)__builtin_amdgcn_s_getreg((3 << 11) | 20) & 0xFu; }
#define XB_SPIN(cond, bar) do { unsigned _sp = 0; while (cond) { __builtin_amdgcn_s_sleep(1); \
    if ((++_sp & 255u) == 0u) { if (xb_ld(&(bar)[XB_TMO])) break; if (_sp > XB_SPIN_CAP) { atomicAdd(&(bar)[XB_TMO], 1u); break; } } } } while (0)

struct XcdBarrier {
    unsigned* bar; unsigned x;
    volatile LAS unsigned* st;
};

__device__ __forceinline__ XcdBarrier xcd_barrier_post(unsigned* bar, volatile LAS unsigned* st) {
    XcdBarrier b; b.bar = bar; b.x = xb_xcc_id(); b.st = st;
    if (threadIdx.x == 0) (void)xb_add(&bar[XB_XCNT(b.x)], 1u);
    return b;
}
__device__ __forceinline__ void xcd_barrier_complete(unsigned* bar, unsigned x, unsigned& nloc, unsigned& nx) {
    const unsigned G = gridDim.x * gridDim.y * gridDim.z;
    unsigned sum, cnt, mine, sp = 0u;
    for (;;) {
        sum = 0u; cnt = 0u; mine = 0u;
#pragma unroll
        for (unsigned j = 0; j < 16; ++j) { const unsigned c = xb_ld(&bar[XB_XCNT(j)]); sum += c; cnt += (c > 0u) ? 1u : 0u; mine = (j == x) ? c : mine; }
        if (sum == G) break;
        __builtin_amdgcn_s_sleep(1);
        if ((++sp & 255u) == 0u) { if (xb_ld(&bar[XB_TMO])) break; if (sp > XB_SPIN_CAP) { atomicAdd(&bar[XB_TMO], 1u); break; } }
    }
    nloc = mine > 0u ? mine : 1u; nx = cnt > 0u ? cnt : 1u;
}

__device__ __forceinline__ void xcd_barrier(const XcdBarrier& b) {
    asm volatile("s_waitcnt vmcnt(0)" ::: "memory");
    __syncthreads();
    if (threadIdx.x == 0) {
        unsigned* bar = b.bar;
        __builtin_amdgcn_s_waitcnt(0);
        unsigned nloc = b.st[0], nx = b.st[1];
        if (nloc == 0u) { xcd_barrier_complete(bar, b.x, nloc, nx); b.st[0] = nloc; b.st[1] = nx; }
        const unsigned old = xb_add(&bar[XB_XSUB(b.x)], 1u);
        const unsigned gen = old / nloc;
        if (old + 1u == (gen + 1u) * nloc) {
            __builtin_amdgcn_fence(__ATOMIC_RELEASE, "agent");
            asm volatile("s_waitcnt vmcnt(0)" ::: "memory");
            const unsigned og = xb_add(&bar[XB_TOP], 1u);
            const unsigned tg = og / nx;
            if (og + 1u == (tg + 1u) * nx) xb_add(&bar[XB_TOPGEN], 1u);
            else XB_SPIN(xb_ld(&bar[XB_TOPGEN]) == tg, bar);
            __builtin_amdgcn_fence(__ATOMIC_ACQUIRE, "agent");
            xb_add(&bar[XB_XGEN(b.x)], 1u);
            asm volatile("s_waitcnt vmcnt(0)" ::: "memory");
        } else {
            XB_SPIN(xb_ld(&bar[XB_XGEN(b.x)]) == gen, bar);
            __builtin_amdgcn_fence(__ATOMIC_ACQUIRE, "agent");
            asm volatile("s_waitcnt vmcnt(0)" ::: "memory");
        }
    }
    __syncthreads();
}

namespace da {
constexpr int KROW = 272, VROW = 144, KT_BYTES = 64 * KROW, VT_BYTES = 128 * VROW, STG = KT_BYTES + VT_BYTES, EXROW = 33;
static_assert(4 * 128 * EXROW * 4 <= 2 * STG && 2 * STG + 128 <= 131072, "attention LDS");
__device__ __forceinline__ unsigned cvtpk(float lo, float hi) { unsigned r; asm volatile("v_cvt_pk_bf16_f32 %0, %1, %2" : "=v"(r) : "v"(lo), "v"(hi)); return r; }
__device__ __forceinline__ bf16x8 pack8f(const f32x16& p, int b) { v4u w; w.x = cvtpk(p[b], p[b + 1]); w.y = cvtpk(p[b + 2], p[b + 3]); w.z = cvtpk(p[b + 4], p[b + 5]); w.w = cvtpk(p[b + 6], p[b + 7]); return __builtin_bit_cast(bf16x8, w); }

__device__ __forceinline__ void attn_unit(LAS unsigned char* lds, int b, int h, int qb, const bf16* Q, const bf16* __restrict__ K, const bf16* __restrict__ VT, bf16* O, float lam, const float* __restrict__ gsub, const float* __restrict__ QN2, const float* __restrict__ KN2) {
    int tid_ = threadIdx.x; asm volatile("" : "+v"(tid_));
    const int tid = tid_, lane = tid & 63, r32 = lane & 31, hi = lane >> 5; const int wid = __builtin_amdgcn_readfirstlane(tid >> 6), c = wid & 1, sub = wid >> 1;
    const int q0 = qb * 128, qrow = q0 + sub * 32 + r32, t0 = q0 >> 6;
    const float sl2 = __builtin_amdgcn_exp2f(-(float)(h + 1)) * LOG2E;
    bf16x8 qf[4];
    { const bf16* qp = Q + ((size_t)b * SEQ + qrow) * DM + h * 128 + c * 64 + hi * 8;
#pragma unroll
      for (int d0 = 0; d0 < 4; ++d0) qf[d0] = *(const bf16x8*)(qp + d0 * 16); }
    const bf16* Kg = K + (size_t)b * SEQ * DM + h * 128 + (size_t)(tid >> 4) * DM + (tid & 15) * 8;
    const bf16* Vg = VT + ((size_t)(b * NH + h) * 128 + (tid >> 3)) * SEQ + (tid & 7) * 8;
    const int kst = (tid >> 4) * KROW + (tid & 15) * 16, vst = (tid >> 3) * VROW + (tid & 7) * 16;
    const int sw = (r32 & ~12) | ((r32 & 4) << 1) | ((r32 & 8) >> 1);
    const int krd = sw * KROW + c * 128 + hi * 16, vrd = r32 * VROW + hi * 16;
    v4u pre[4];
#define DA_LOADK(t) do { const int kv0_ = (t) * 64; pre[0] = *(const v4u*)(Kg + (size_t)kv0_ * DM); pre[1] = *(const v4u*)(Kg + (size_t)(kv0_ + 32) * DM); } while (0)
#define DA_LOADV(t) do { const int kv0_ = (t) * 64; pre[2] = *(const v4u*)(Vg + kv0_); pre[3] = *(const v4u*)(Vg + (size_t)64 * SEQ + kv0_); } while (0)
#define DA_STOREK(kbuf) do { LAS unsigned char* s_ = lds + (kbuf) * KT_BYTES + kst; *(LAS v4u*)(s_) = pre[0]; *(LAS v4u*)(s_ + 32 * KROW) = pre[1]; } while (0)
#define DA_STOREV(vbuf) do { LAS unsigned char* s_ = lds + 2 * KT_BYTES + (vbuf) * VT_BYTES + vst; *(LAS v4u*)(s_) = pre[2]; *(LAS v4u*)(s_ + 64 * VROW) = pre[3]; } while (0)
    int t_lo, nt;
    {
        float k0m = 0.f, k1m = 0.f, q0m = 0.f, q1m = 0.f;
        { const f32x4* kn0 = (const f32x4*)(KN2 + (size_t)(2 * h) * 32768 + (size_t)b * SEQ) + tid * 2; const f32x4* kn1 = kn0 + 32768 / 4;
          const f32x4 a0 = kn0[0], a1 = kn0[1], b0 = kn1[0], b1 = kn1[1];
          k0m = __builtin_fmaxf(__builtin_fmaxf(__builtin_fmaxf(a0[0], a0[1]), __builtin_fmaxf(a0[2], a0[3])), __builtin_fmaxf(__builtin_fmaxf(a1[0], a1[1]), __builtin_fmaxf(a1[2], a1[3])));
          k1m = __builtin_fmaxf(__builtin_fmaxf(__builtin_fmaxf(b0[0], b0[1]), __builtin_fmaxf(b0[2], b0[3])), __builtin_fmaxf(__builtin_fmaxf(b1[0], b1[1]), __builtin_fmaxf(b1[2], b1[3]))); }
        if (tid < 128) { const float* qn = QN2 + (size_t)(2 * h) * 32768 + (size_t)b * SEQ + q0 + tid; q0m = qn[0]; q1m = qn[32768]; }
        float dmin;
        { const bf16* kp = K + ((size_t)b * SEQ + qrow) * DM + h * 128 + c * 64 + hi * 8; float sp = 0.f;
#pragma unroll
          for (int d0 = 0; d0 < 4; ++d0) { const bf16x8 kd = *(const bf16x8*)(kp + d0 * 16);
#pragma unroll
              for (int j2 = 0; j2 < 8; ++j2) sp += __uint_as_float((unsigned)(unsigned short)qf[d0][j2] << 16) * __uint_as_float((unsigned)(unsigned short)kd[j2] << 16); }
          sp += __shfl_xor(sp, 32); dmin = sp;
#pragma unroll
          for (int o_ = 1; o_ < 32; o_ <<= 1) dmin = __builtin_fminf(dmin, __shfl_xor(dmin, o_)); }
#pragma unroll
        for (int o_ = 1; o_ < 64; o_ <<= 1) { k0m = __builtin_fmaxf(k0m, __shfl_xor(k0m, o_)); k1m = __builtin_fmaxf(k1m, __shfl_xor(k1m, o_)); q0m = __builtin_fmaxf(q0m, __shfl_xor(q0m, o_)); q1m = __builtin_fmaxf(q1m, __shfl_xor(q1m, o_)); }
        LAS float* red = (LAS float*)(lds + 2 * STG);
        if (lane == 0) { red[wid * 4 + 0] = k0m; red[wid * 4 + 1] = k1m; red[wid * 4 + 2] = q0m; red[wid * 4 + 3] = q1m; red[32 + wid] = dmin; }
        __syncthreads();
        k0m = 0.f; k1m = 0.f; q0m = 0.f; q1m = 0.f;
#pragma unroll
        for (int w_ = 0; w_ < 8; ++w_) { k0m = __builtin_fmaxf(k0m, red[w_ * 4 + 0]); k1m = __builtin_fmaxf(k1m, red[w_ * 4 + 1]); q0m = __builtin_fmaxf(q0m, red[w_ * 4 + 2]); q1m = __builtin_fmaxf(q1m, red[w_ * 4 + 3]); }
        const float Bq = 1.02f * __builtin_fmaxf(__builtin_sqrtf(k0m * q0m), __builtin_sqrtf(k1m * q1m));
        float dm = red[32];
#pragma unroll
        for (int w_ = 1; w_ < 8; ++w_) dm = __builtin_fminf(dm, red[32 + w_]);
        dm = __builtin_fmaxf(dm - 0.25f, -Bq);
        const float Rf = (Bq - dm + 40.f) / sl2;
        const int R = Rf < 8192.f ? (int)Rf + 1 : 8192;
        int lo = (q0 - 63 - R); lo = lo <= 0 ? 0 : (lo + 63) >> 6; int hi_t = (q0 + 127 + R) >> 6; hi_t = hi_t > 63 ? 63 : hi_t;
        t_lo = __builtin_amdgcn_readfirstlane(lo); nt = __builtin_amdgcn_readfirstlane(hi_t - lo + 1);
    }
    f32x16 o[4];
#pragma unroll
    for (int i = 0; i < 4; ++i)
#pragma unroll
        for (int r = 0; r < 16; ++r) o[i][r] = 0.f;
    float mref = 0.f;
    float lsum = 0.f;
#define DA_TILE(j_) (t_lo + (((t0 - t_lo) + (j_)) >= nt ? ((t0 - t_lo) + (j_)) - nt : ((t0 - t_lo) + (j_))))
    const float qposf = (float)(qrow - 8 * hi);
    const int grp = wid >> 2;
#define DA_BAR() do { asm volatile("s_waitcnt lgkmcnt(0)" ::: "memory"); __builtin_amdgcn_s_barrier(); asm volatile("" ::: "memory"); } while (0)
#define DA_CINIT(tn) do { const int tn_ = (tn); const float dln_ = qposf - (float)(tn_ * 64); \
        if (tn_ < t0 || tn_ > t0 + 1) { const float ss_ = (tn_ < t0) ? sl2 : -sl2; const float base_ = -ss_ * dln_ - mref; \
            _Pragma("unroll") for (int r = 0; r < 16; ++r) { const float cr = (float)((r & 7) + 16 * (r >> 3)); p0[r] = __builtin_fmaf(cr, ss_, base_); p1[r] = __builtin_fmaf(cr + 32.f, ss_, base_); } } \
        else { _Pragma("unroll") for (int r = 0; r < 16; ++r) { const float cr = (float)((r & 7) + 16 * (r >> 3)); \
            p0[r] = __builtin_fmaf(-sl2, __builtin_fabsf(dln_ - cr), -mref); p1[r] = __builtin_fmaf(-sl2, __builtin_fabsf(dln_ - (cr + 32.f)), -mref); } } } while (0)
#define DA_QK(kbuf) do { const LAS unsigned char* kb_ = lds + (kbuf) * KT_BYTES + krd; \
        _Pragma("unroll") for (int d0 = 0; d0 < 4; ++d0) { const bf16x8 a0 = *(const LAS bf16x8*)(kb_ + d0 * 32), a1 = *(const LAS bf16x8*)(kb_ + 32 * KROW + d0 * 32); \
            p0 = __builtin_amdgcn_mfma_f32_32x32x16_bf16(a0, qf[d0], p0, 0, 0, 0); p1 = __builtin_amdgcn_mfma_f32_32x32x16_bf16(a1, qf[d0], p1, 0, 0, 0); } } while (0)
    f32x16 p0, p1;
    DA_LOADK(DA_TILE(0)); DA_LOADV(DA_TILE(0)); DA_STOREK(0); DA_STOREV(0);
    if (nt > 1) { DA_LOADK(DA_TILE(1)); DA_STOREK(1); }
    __syncthreads();
    DA_CINIT(DA_TILE(0)); DA_QK(0);
    if (grp == 1) DA_BAR();
    for (int j = 0; j < nt; ++j) {
        const int t = DA_TILE(j);
        if (j + 2 < nt) DA_LOADK(DA_TILE(j + 2));
        if (j + 1 < nt) DA_LOADV(DA_TILE(j + 1));
        float tm;
        { float ma = __builtin_fmaxf(p0[0], p1[0]), mb = __builtin_fmaxf(p0[1], p1[1]);
#pragma unroll
          for (int r = 2; r < 16; r += 2) { ma = __builtin_fmaxf(__builtin_fmaxf(ma, p0[r]), p1[r]); mb = __builtin_fmaxf(__builtin_fmaxf(mb, p0[r + 1]), p1[r + 1]); }
          tm = __builtin_fmaxf(ma, mb); }
        tm = __builtin_fmaxf(tm, __shfl_xor(tm, 32));
        if (j == 0 || __any(tm > 8.f)) {
            const float dq = (j == 0) ? tm : __builtin_fmaxf(tm, 0.f), al = (j == 0) ? 1.f : __builtin_amdgcn_exp2f(-dq);
            mref += dq;
#pragma unroll
            for (int r = 0; r < 16; ++r) { p0[r] -= dq; p1[r] -= dq; }
            lsum *= al;
#pragma unroll
            for (int i = 0; i < 4; ++i)
#pragma unroll
                for (int r = 0; r < 16; ++r) o[i][r] *= al;
        }
        { float rs0 = 0.f, rs1 = 0.f;
#pragma unroll
        for (int r = 0; r < 16; ++r) { p0[r] = __builtin_amdgcn_exp2f(p0[r]); p1[r] = __builtin_amdgcn_exp2f(p1[r]); rs0 += p0[r]; rs1 += p1[r]; }
        lsum += rs0 + rs1; }
        bf16x8 pf[4]; pf[0] = pack8f(p0, 0); pf[1] = pack8f(p0, 8); pf[2] = pack8f(p1, 0); pf[3] = pack8f(p1, 8);
        if (j + 1 < nt) DA_CINIT(DA_TILE(j + 1));
        DA_BAR();
        { const LAS unsigned char* vb_ = lds + 2 * KT_BYTES + (j & 1) * VT_BYTES + vrd;
          const LAS unsigned char* kb_ = lds + ((j + 1) & 1) * KT_BYTES + krd;
          const bool hasn = (j + 1 < nt);
          bf16x8 fa[4], fb[4];
#define DA_RDV(dst, db) _Pragma("unroll") for (int i = 0; i < 4; ++i) dst[i] = *(const LAS bf16x8*)(vb_ + (db) * 32 * VROW + i * 32)
#define DA_RDK(dst, h2) _Pragma("unroll") for (int i = 0; i < 4; ++i) dst[i] = *(const LAS bf16x8*)(kb_ + (i & 1) * 32 * KROW + ((h2) * 2 + (i >> 1)) * 32)
#define DA_PV(src, db) _Pragma("unroll") for (int i = 0; i < 4; ++i) o[db] = __builtin_amdgcn_mfma_f32_32x32x16_bf16(src[i], pf[i], o[db], 0, 0, 0)
#define DA_SB() __builtin_amdgcn_sched_barrier(0)
          DA_RDV(fa, 0); DA_SB(); DA_RDV(fb, 1); DA_SB();
          DA_PV(fa, 0); DA_SB(); DA_RDV(fa, 2); DA_SB();
          DA_PV(fb, 1); DA_SB(); DA_RDV(fb, 3); DA_SB();
          DA_PV(fa, 2); DA_SB();
          if (hasn) { DA_RDK(fa, 0); } DA_SB();
          DA_PV(fb, 3);
          DA_SB();
          if (hasn) {
              DA_RDK(fb, 1); DA_SB();
              p0 = __builtin_amdgcn_mfma_f32_32x32x16_bf16(fa[0], qf[0], p0, 0, 0, 0); p1 = __builtin_amdgcn_mfma_f32_32x32x16_bf16(fa[1], qf[0], p1, 0, 0, 0);
              p0 = __builtin_amdgcn_mfma_f32_32x32x16_bf16(fa[2], qf[1], p0, 0, 0, 0); p1 = __builtin_amdgcn_mfma_f32_32x32x16_bf16(fa[3], qf[1], p1, 0, 0, 0);
              DA_SB();
              p0 = __builtin_amdgcn_mfma_f32_32x32x16_bf16(fb[0], qf[2], p0, 0, 0, 0); p1 = __builtin_amdgcn_mfma_f32_32x32x16_bf16(fb[1], qf[2], p1, 0, 0, 0);
              p0 = __builtin_amdgcn_mfma_f32_32x32x16_bf16(fb[2], qf[3], p0, 0, 0, 0); p1 = __builtin_amdgcn_mfma_f32_32x32x16_bf16(fb[3], qf[3], p1, 0, 0, 0);
          }
#undef DA_RDV
#undef DA_RDK
#undef DA_PV
#undef DA_SB
        }
        if (j + 2 < nt) DA_STOREK(j & 1);
        if (j + 1 < nt) DA_STOREV((j + 1) & 1);
        DA_BAR();
    }
    if (grp == 0) DA_BAR();
#undef DA_LOADK
#undef DA_LOADV
#undef DA_STOREK
#undef DA_STOREV
#undef DA_QK
#undef DA_CINIT
#undef DA_BAR
#undef DA_TILE
    lsum += __shfl_xor(lsum, 32);
    const float inv = 1.0f / lsum;
    LAS float* ex = (LAS float*)lds + sub * (128 * EXROW);
    if (c == 1) {
#pragma unroll
        for (int db = 0; db < 4; ++db)
#pragma unroll
            for (int r = 0; r < 16; ++r) ex[(32 * db + (r & 3) + 8 * (r >> 2) + 4 * hi) * EXROW + r32] = o[db][r] * inv;
    }
    __syncthreads();
    if (c == 0) {
        float ssq = 0.f;
#pragma unroll
        for (int db = 0; db < 4; ++db)
#pragma unroll
            for (int r = 0; r < 16; ++r) { const float v = o[db][r] * inv - lam * ex[(32 * db + (r & 3) + 8 * (r >> 2) + 4 * hi) * EXROW + r32]; o[db][r] = v; ssq += v * v; }
        ssq += __shfl_xor(ssq, 32);
        const float rstd = __builtin_amdgcn_rsqf(ssq * (1.0f / 128.0f) + 1e-6f) * 0.8f;
        bf16* op = O + ((size_t)b * SEQ + qrow) * DM + h * 128;
#pragma unroll
        for (int db = 0; db < 4; ++db)
#pragma unroll
            for (int rg = 0; rg < 4; ++rg) { const int d = 32 * db + 8 * rg + 4 * hi; const f32x4 g = *(const f32x4*)(gsub + d);
                v2u w; w.x = cvtpk(o[db][4 * rg] * rstd * g[0], o[db][4 * rg + 1] * rstd * g[1]); w.y = cvtpk(o[db][4 * rg + 2] * rstd * g[2], o[db][4 * rg + 3] * rstd * g[3]);
                *(v2u*)(op + d) = w; }
    }
    __syncthreads();
}
}

struct TrDesc { const float* W; int ldw, col0, K, ncols; bf16* WT; int row0, ilv; const float* ks; };
__device__ __forceinline__ void transpose_item(const TrDesc& d, LAS float* scr, int item, int lane) {
    const int nblk = d.ncols / 32, kb = item / nblk, nb = item % nblk, k0 = 64 * kb, n0 = 32 * nb;
    { const float* src = d.W + (size_t)(k0 + (lane >> 3)) * d.ldw + d.col0 + n0 + (lane & 7) * 4; const size_t st8 = (size_t)8 * d.ldw;
      f32x4 w[8];
#pragma unroll
      for (int i = 0; i < 8; ++i) w[i] = __builtin_nontemporal_load((const f32x4*)(src + (size_t)i * st8));
      if (d.ks) {
#pragma unroll
        for (int i = 0; i < 8; ++i) w[i] = w[i] * d.ks[k0 + (lane >> 3) + 8 * i]; }
#pragma unroll
      for (int i = 0; i < 8; ++i) { LAS float* p = scr + ((lane >> 3) + 8 * i) * 33 + (lane & 7) * 4; p[0] = w[i].x; p[1] = w[i].y; p[2] = w[i].z; p[3] = w[i].w; } }
    asm volatile("s_waitcnt lgkmcnt(0)" ::: "memory");
    const int c = lane & 7;
#pragma unroll
    for (int j = 0; j < 4; ++j) { const int n = (lane >> 3) + 8 * j; const LAS float* s = scr + (8 * c) * 33 + n;
        v4u o; o.x = pk2(s[0 * 33], s[1 * 33]); o.y = pk2(s[2 * 33], s[3 * 33]); o.z = pk2(s[4 * 33], s[5 * 33]); o.w = pk2(s[6 * 33], s[7 * 33]);
        const int nn = n0 + n; const int drow = d.ilv < 0 ? d.row0 + nn : 256 * (nn >> 7) + (nn & 127) + d.ilv;
        __builtin_nontemporal_store(o, (v4u*)(d.WT + (size_t)drow * d.K + k0 + 8 * c)); }
    asm volatile("s_waitcnt lgkmcnt(0)" ::: "memory");
}

struct Args { const float* in[22]; float* out; unsigned char* ws; };
__device__ __forceinline__ const float* kin_ptr(int i) { const __attribute__((address_space(4))) char* kp = (const __attribute__((address_space(4))) char*)__builtin_amdgcn_kernarg_segment_ptr();
    asm volatile("" : "+s"(kp)); return *(const float* const __attribute__((address_space(4)))*)(kp + 8 * i); }

__global__ void __launch_bounds__(512, 2) fwd_megakernel(Args a) {
    extern __shared__ __attribute__((aligned(16))) unsigned char lds_raw[];
    LAS unsigned char* lds = (LAS unsigned char*)lds_raw;
    cg::grid_group grid = cg::this_grid();
    const int tid = threadIdx.x, lane = tid & 63, wave = __builtin_amdgcn_readfirstlane(tid >> 6);
    const int G = gridDim.x, bid = blockIdx.x;
    if (tid < 2) ((volatile LAS unsigned*)(lds + LDS_XB_OFF))[tid] = 0u;
    __syncthreads();
    const XcdBarrier xbar = xcd_barrier_post((unsigned*)((unsigned char*)kin_ptr(23) + WS_XBAR), (volatile LAS unsigned*)(lds + LDS_XB_OFF));
#define KIN(i) kin_ptr(i)
#define xin KIN(0)
#define pin KIN(1)
#define g_mix KIN(2)
#define w_in KIN(3)
#define lq1 KIN(4)
#define lk1 KIN(5)
#define lq2 KIN(6)
#define lk2 KIN(7)
#define g_subln KIN(8)
#define w_fo KIN(9)
#define w_ao KIN(10)
#define w_bg KIN(11)
#define b_bg KIN(12)
#define w_o KIN(13)
#define g_ffn KIN(14)
#define w_fg KIN(15)
#define w_fu KIN(16)
#define w_fd KIN(17)
#define g_ple KIN(18)
#define w_pg KIN(19)
#define w_pp KIN(20)
#define g_final KIN(21)
#define out ((float*)KIN(22))
#define ws ((unsigned char*)KIN(23))
#define ss1 ((float*)(ws + WS_CTL))
#define ss2 (ss1 + MTOK)
#define ss3 (ss1 + 2 * MTOK)
#define W1t ((bf16*)(ws + WS_W1T))
#define W2t ((bf16*)(ws + WS_W2T))
#define Wft ((bf16*)(ws + WS_WFT))
#define Wat ((bf16*)(ws + WS_WAT))
#define Wot ((bf16*)(ws + WS_WOT))
#define Wgut ((bf16*)(ws + WS_WGUT))
#define Wdt ((bf16*)(ws + WS_WDT))
#define Wpgt ((bf16*)(ws + WS_WPGT))
#define Wppt ((bf16*)(ws + WS_WPPT))
#define Pb ((bf16*)(ws + WS_PB))
#define XN ((bf16*)(ws + WS_XN))
#define Yb ((bf16*)(ws + WS_ZT))
#define X1b XN
#define Qb ((bf16*)(ws + WS_Q))
#define Ob Qb
#define Kb ((bf16*)(ws + WS_K))
#define MG Kb
#define VT ((bf16*)(ws + WS_VT))
#define PP VT
#define ZT ((bf16*)(ws + WS_ZT))
#define Hb ZT
#define XNp ((bf16*)(ws + WS_DM))
#define Gt ((bf16*)out)
#define T32 ((bf16*)(ws + WS_T32))
    const int gw = bid * 8 + wave, NGW = G * 8, gt = bid * 512 + tid, NGT = G * 512;

    PH_BEGIN(0)
    {
        LAS float* scr = (LAS float*)(lds + wave * 16384);
        constexpr int NI[12] = {512, 512, 1024, 512, 512, 512, 512, 1408, 1408, 1408, 512, 128};
        constexpr int NITEMS = 512 * 7 + 1024 + 1408 * 3 + 128;
        for (int it = gw; it < NITEMS; it += NGW) {
            int r = it, mi = 0;
#pragma unroll
            for (int q = 0; q < 11; ++q) { if (mi == q && r >= NI[q]) { r -= NI[q]; mi = q + 1; } }
            TrDesc d;
            switch (mi) {
                case 0: d = TrDesc{w_in, 4096, 1024, 1024, 1024, W1t, 0, -1, nullptr}; break;
                case 1: d = TrDesc{w_in, 4096, 2048, 1024, 1024, W1t, 1024, -1, nullptr}; break;
                case 2: d = TrDesc{w_bg, 2048, 0, 1024, 2048, W1t, 2048, -1, nullptr}; break;
                case 3: d = TrDesc{w_in, 4096, 3072, 1024, 1024, W2t, 1024, -1, nullptr}; break;
                case 4: d = TrDesc{w_fo, 1024, 0, 1024, 1024, Wft, 0, -1, nullptr}; break;
                case 5: d = TrDesc{w_ao, 1024, 0, 1024, 1024, Wat, 0, -1, nullptr}; break;
                case 6: d = TrDesc{w_o, 1024, 0, 1024, 1024, Wot, 0, -1, nullptr}; break;
                case 7: d = TrDesc{w_fg, 2816, 0, 1024, 2816, Wgut, 0, 0, g_ffn}; break;
                case 8: d = TrDesc{w_fu, 2816, 0, 1024, 2816, Wgut, 0, 128, g_ffn}; break;
                case 9: d = TrDesc{w_fd, 1024, 0, 2816, 1024, Wdt, 0, -1, nullptr}; break;
                case 10: d = TrDesc{w_pg, 1024, 0, 1024, 1024, Wpgt, 0, -1, g_ple}; break;
                default: d = TrDesc{w_pp, 1024, 0, 256, 1024, Wppt, 0, -1, nullptr}; break;
            }
            transpose_item(d, scr, r, lane);
        }
        {
            LAS float* Wl = scr;
            LAS float* T = scr + 1024;
            T[lane] = cospif((float)lane * (1.0f / 64.0f)); T[lane + 64] = cospif((float)(lane + 64) * (1.0f / 64.0f));
            for (int it = gw; it < 1024; it += NGW) {
                const int kb8 = it >> 3, g = it & 7, k0 = kb8 * 8;
                asm volatile("s_waitcnt lgkmcnt(0)" ::: "memory");
#pragma unroll
                for (int kk = 0; kk < 8; ++kk) { Wl[kk * 128 + lane] = w_in[(size_t)(k0 + kk) * 4096 + g * 128 + lane]; Wl[kk * 128 + 64 + lane] = w_in[(size_t)(k0 + kk) * 4096 + g * 128 + 64 + lane]; }
                asm volatile("s_waitcnt lgkmcnt(0)" ::: "memory");
                float ac[2][2][8];
#pragma unroll
                for (int i = 0; i < 2; ++i)
#pragma unroll
                    for (int j = 0; j < 2; ++j)
#pragma unroll
                        for (int k = 0; k < 8; ++k) ac[i][j][k] = 0.f;
                const int m0 = lane, m1 = lane + 64;
                for (int c = 0; c < 128; ++c) {
                    const int i0 = (c * m0) & 127, i1 = (c * m1) & 127;
                    const float c0 = T[i0], s0 = T[(i0 + 96) & 127], c1 = T[i1], s1 = T[(i1 + 96) & 127];
#pragma unroll
                    for (int k = 0; k < 8; ++k) { const float w = Wl[k * 128 + c]; ac[0][0][k] += w * c0; ac[0][1][k] += w * s0; ac[1][0][k] += w * c1; ac[1][1][k] += w * s1; }
                }
                const float sc = 0.08838834764831845f;
#pragma unroll
                for (int i = 0; i < 2; ++i)
#pragma unroll
                    for (int j = 0; j < 2; ++j) { const int mm = (i ? m1 : m0); const bool valid = j == 0 ? (mm <= 64) : (mm >= 1 && mm <= 63);
                        const int n = j == 0 ? g * 65 + mm : 520 + g * 63 + mm - 1;
                        v4u o; o.x = pk2(ac[i][j][0] * sc, ac[i][j][1] * sc); o.y = pk2(ac[i][j][2] * sc, ac[i][j][3] * sc); o.z = pk2(ac[i][j][4] * sc, ac[i][j][5] * sc); o.w = pk2(ac[i][j][6] * sc, ac[i][j][7] * sc);
                        if (valid) *(v4u*)(W2t + (size_t)n * 1024 + k0) = o; }
            }
        }
        for (int m = gw; m < MTOK; m += 4 * NGW) {
            f32x4 v[4][4]; float sq[4]; int mr[4];
#pragma unroll
            for (int q = 0; q < 4; ++q) { const int mq = m + q * NGW; mr[q] = mq < MTOK ? mq : m; const f32x4* xr = (const f32x4*)(xin + (size_t)mr[q] * DM) + lane;
#pragma unroll
                for (int j = 0; j < 4; ++j) v[q][j] = __builtin_nontemporal_load(&xr[64 * j]); }
            f32x4 gm[4];
#pragma unroll
            for (int j = 0; j < 4; ++j) gm[j] = ((const f32x4*)g_mix)[lane + 64 * j];
#pragma unroll
            for (int q = 0; q < 4; ++q) { float s_ = 0.f;
#pragma unroll
                for (int j = 0; j < 4; ++j) s_ += (v[q][j].x * v[q][j].x + v[q][j].y * v[q][j].y) + (v[q][j].z * v[q][j].z + v[q][j].w * v[q][j].w);
                sq[q] = s_; }
#pragma unroll
            for (int o_ = 1; o_ < 64; o_ <<= 1) {
#pragma unroll
                for (int q = 0; q < 4; ++q) sq[q] += __shfl_xor(sq[q], o_); }
#pragma unroll
            for (int q = 0; q < 4; ++q) { if (m + q * NGW < MTOK) {
                const float rstd = __builtin_amdgcn_rsqf(sq[q] * (1.0f / 1024.0f) + 1e-6f); const int mm = mr[q], mp = (mm & ~4095) | ((mm & 63) << 6) | ((mm >> 6) & 63);
                unsigned long long* o8 = (unsigned long long*)(XN + (size_t)mm * DM) + lane; unsigned long long* q8 = (unsigned long long*)(XNp + (size_t)mp * DM) + lane;
#pragma unroll
                for (int j = 0; j < 4; ++j) { const f32x4 g = gm[j], x_ = v[q][j];
                    const unsigned long long w1 = (unsigned long long)pk2(x_.x * rstd * g.x, x_.y * rstd * g.y) | ((unsigned long long)pk2(x_.z * rstd * g.z, x_.w * rstd * g.w) << 32);
                    o8[64 * j] = w1; q8[64 * j] = w1; } } }
        }
        { const v4u z = {0u, 0u, 0u, 0u};
          for (int i = gt; i < 8 * 8 * 2 * 64 * 8; i += NGT) { const int ch = i & 7, s2 = (i >> 3) & 63, mm = ((i >> 9) & 1) * 64, g = (i >> 10) & 7, b = i >> 13;
              *(v4u*)(ZT + (((size_t)(b * 640 + g * 80 + mm) * 64 + s2) * 128 + 64 + ch * 8)) = z; } }
        for (int i = gt; i < MTOK * PLE / 8; i += 4 * NGT) { f32x4 a0[4], a1[4];
#pragma unroll
            for (int q = 0; q < 4; ++q) { const int iq = (i + q * NGT < MTOK * PLE / 8) ? i + q * NGT : i; a0[q] = __builtin_nontemporal_load(&((const f32x4*)pin)[2 * iq]); a1[q] = __builtin_nontemporal_load(&((const f32x4*)pin)[2 * iq + 1]); }
#pragma unroll
            for (int q = 0; q < 4; ++q) { if (i + q * NGT < MTOK * PLE / 8) { v4u o; o.x = pk2(a0[q].x, a0[q].y); o.y = pk2(a0[q].z, a0[q].w); o.z = pk2(a1[q].x, a1[q].y); o.w = pk2(a1[q].z, a1[q].w); __builtin_nontemporal_store(o, &((v4u*)Pb)[i + q * NGT]); } } }
        { bf16* F1 = (bf16*)(ws + WS_F1); bf16* F3 = (bf16*)(ws + WS_F3); float* TWp = (float*)(ws + WS_TW);
          for (int i = gt; i < 32768; i += NGT) { const int rt = i >> 7, Kc = i & 127; float v1 = 0.f, v3 = 0.f;
              if (rt < 128) { const int m_ = (rt >> 4) & 3, ri = m_ & 1, k1 = 32 * (rt >> 6) + 16 * (m_ >> 1) + (rt & 15), part = Kc >> 6, s1 = Kc & 63; const float x = (float)((k1 * s1) & 63) * (1.0f / 32.0f);
                  const float cv = cospif(x), sv = sinpif(x); v1 = ri == 0 ? (part == 0 ? cv : -sv) : (part == 0 ? sv : cv); }
              if (rt < 64) { const int ri = Kc >> 6, s2 = Kc & 63; const float x = (float)((rt * s2) & 63) * (1.0f / 32.0f); v3 = (ri == 0 ? cospif(x) : -sinpif(x)) * (1.0f / 64.0f); }
              F1[i] = (bf16)f2bf(v1); F3[i] = (bf16)f2bf(v3); }
          for (int i = gt; i < 4096; i += NGT) { const int k1 = i >> 6, s2 = i & 63; const float x = (float)(k1 * s2) * (1.0f / 2048.0f); TWp[2 * i] = cospif(x); TWp[2 * i + 1] = sinpif(x); } }
    }
    PH_END(0)
    if (G == 0x7fffffff) grid.sync();
    xcd_barrier(xbar);

    PH_BEGIN(1)
#ifndef NO_G1A
    { pg8::Gemm g{XN, W1t, MTOK, 4096, 1024}; pg8::StaticOrder S; S.init(MTOK, 4096, G, bid);
      pg8::EpiQKG E{Qb, Kb, Gt, b_bg, 0.125f * LOG2E};
      pg8::gemm_phase<pg8::EpiQKG, pg8::StaticOrder, true, true>(lds, g, S, E); }
#endif
#ifndef NO_G1B
    { pg8::Gemm g{W2t, XNp, 1024, MTOK, 1024}; pg8::StaticOrder S; S.init(1024, MTOK, G, bid);
      pg8::EpiZ4 E{ZT};
      pg8::gemm_phase<pg8::EpiZ4, pg8::StaticOrder, true, true>(lds, g, S, E); }
    { pg8::Gemm g{W2t + (size_t)1024 * 1024, XN, 1024, MTOK, 1024}; pg8::StaticOrder S; S.init(1024, MTOK, G, bid);
      pg8::EpiVT E{VT};
      pg8::gemm_phase<pg8::EpiVT, pg8::StaticOrder, true, true>(lds, g, S, E); }
#endif
    PH_END(1)
    xcd_barrier(xbar);
#if PROBE_PHASE == 99
    PH_BEGIN(99)
    grid.sync();
    PH_END(99)
#endif

    PH_BEGIN(20)
#ifndef NO_G2
    { int k128 = 128; asm volatile("" : "+s"(k128));
      { pg8::Gemm g{(const bf16*)(ws + WS_F1), ZT, 256, 327680, k128}; pg8::StaticOrder S; S.init(256, 327680, G, bid);
        pg8::EpiG E{(const float*)(ws + WS_TW), (bf16*)(ws + WS_XN), (bf16*)(ws + WS_DM)};
        pg8::gemm_phase<pg8::EpiG, pg8::StaticOrder, true, true>(lds, g, S, E); }
      xcd_barrier(xbar);
      { pg8::Gemm g{(const bf16*)(ws + WS_F3), (const bf16*)(ws + WS_XN), 256, 163840, k128}; pg8::StaticOrder S; S.init(256, 163840, G, bid);
        pg8::EpiY3 E{Yb, 0};
        pg8::gemm_phase<pg8::EpiY3, pg8::StaticOrder, true, true>(lds, g, S, E); }
      { pg8::Gemm g{(const bf16*)(ws + WS_F3), (const bf16*)(ws + WS_DM), 256, 163840, k128}; pg8::StaticOrder S; S.init(256, 163840, G, (bid + (G >> 1)) % G);
        pg8::EpiY3 E{Yb, 4};
        pg8::gemm_phase<pg8::EpiY3, pg8::StaticOrder, true, true>(lds, g, S, E); } }
#endif
    PH_END(20)
    PH_BEGIN(21)
    {
        const float d1 = wave_sum(lq1[lane] * lk1[lane]), d2 = wave_sum(lq2[lane] * lk2[lane]);
        const float lam = __expf(d1) - __expf(d2) + 0.2f;
        for (int u = bid; u < 2048; u += G) { const int xcd = u & 7, w = u >> 3, bh = xcd * 8 + (w >> 5), qb = ((w >> 5) & 1) ? ((w + 16) & 31) : (w & 31);
#ifndef NO_ATT
            da::attn_unit(lds, bh >> 3, bh & 7, qb, Qb, Kb, VT, Ob, lam, g_subln, (const float*)(ws + WS_QN2), (const float*)(ws + WS_KN2));
#endif
        }
    }
    PH_END(21)
    xcd_barrier(xbar);

    PH_BEGIN(3)
#ifndef NO_G3A
    { pg8::Gemm g{Yb, Wft, MTOK, 1024, 1024}; pg8::StaticOrder S; S.init(MTOK, 1024, G, bid);
      pg8::EpiGateF E{Gt, T32};
      pg8::gemm_phase<pg8::EpiGateF, pg8::StaticOrder, true, true>(lds, g, S, E); }
#endif
#ifndef NO_G3B
    { pg8::Gemm g{Ob, Wat, MTOK, 1024, 1024}; pg8::StaticOrder S; S.init(MTOK, 1024, G, bid);
      pg8::EpiGateA E{Gt, T32, MG};
      pg8::gemm_phase<pg8::EpiGateA, pg8::StaticOrder, true, true>(lds, g, S, E); }
#endif
    PH_END(3)
    xcd_barrier(xbar);

    PH_BEGIN(4)
#ifndef NO_G4A
    { pg8::Gemm g{MG, Wot, MTOK, 1024, 1024}; pg8::StaticOrder S; S.init(MTOK, 1024, G, bid);
      pg8::EpiResid<false> E{xin, X1b, ss1};
      pg8::gemm_phase<pg8::EpiResid<false>, pg8::StaticOrder, true, true>(lds, g, S, E); }
#endif
#ifndef NO_G4B
    { int kpp = 256; asm volatile("" : "+s"(kpp)); pg8::Gemm g{Pb, Wppt, MTOK, 1024, kpp}; pg8::StaticOrder S; S.init(MTOK, 1024, G, bid);
      pg8::EpiPlain E{PP, 1024};
      pg8::gemm_phase<pg8::EpiPlain, pg8::StaticOrder, true, true>(lds, g, S, E); }
#endif
    PH_END(4)
    xcd_barrier(xbar);

    PH_BEGIN(5)
#ifndef NO_G5
    { pg8::Gemm g{X1b, Wgut, MTOK, 2 * DFF, 1024}; pg8::StaticOrder S; S.init(MTOK, 2 * DFF, G, bid);
      pg8::EpiSwiGLU E{ss1, Hb};
      pg8::gemm_phase<pg8::EpiSwiGLU, pg8::StaticOrder, true, true>(lds, g, S, E); }
#endif
    PH_END(5)
    xcd_barrier(xbar);

    PH_BEGIN(6)
#ifndef NO_G6
    { pg8::Gemm g{Hb, Wdt, MTOK, 1024, DFF}; pg8::StaticOrder S; S.init(MTOK, 1024, G, bid);
      pg8::EpiResid<true> E{X1b, X1b, ss2};
      pg8::gemm_phase<pg8::EpiResid<true>, pg8::StaticOrder, true, true>(lds, g, S, E); }
#endif
    PH_END(6)
    xcd_barrier(xbar);

    PH_BEGIN(7)
#ifndef NO_G7
    { pg8::Gemm g{X1b, Wpgt, MTOK, 1024, 1024}; pg8::StaticOrder S; S.init(MTOK, 1024, G, bid);
      pg8::EpiPle E{ss2, PP, X1b, Qb, ss3};
      pg8::gemm_phase<pg8::EpiPle, pg8::StaticOrder, true, true>(lds, g, S, E); }
#endif
    PH_END(7)
    xcd_barrier(xbar);

    for (int m = gw; m < MTOK; m += NGW) {
        f32x4* xr = (f32x4*)(out + (size_t)m * DM) + lane; const v2u* xb = (const v2u*)(Qb + (size_t)m * DM) + lane;
        const float rstd = __builtin_amdgcn_rsqf(ss3[m] * (1.0f / 1024.0f) + 1e-6f);
#pragma unroll
        for (int j = 0; j < 4; ++j) { const f32x4 g = ((const f32x4*)g_final)[lane + 64 * j]; const v2u w = __builtin_nontemporal_load(&xb[64 * j]);
            const f32x4 v = {__uint_as_float(w.x << 16), __uint_as_float(w.x & 0xffff0000u), __uint_as_float(w.y << 16), __uint_as_float(w.y & 0xffff0000u)};
            __builtin_nontemporal_store(v * rstd * g, &xr[64 * j]); }
    }
}

#undef xin
#undef pin
#undef g_mix
#undef w_in
#undef lq1
#undef lk1
#undef lq2
#undef lk2
#undef g_subln
#undef w_fo
#undef w_ao
#undef w_bg
#undef b_bg
#undef w_o
#undef g_ffn
#undef w_fg
#undef w_fu
#undef w_fd
#undef g_ple
#undef w_pg
#undef w_pp
#undef g_final
#undef out
#undef ws
#undef ss1
#undef ss2
#undef ss3
#undef W1t
#undef W2t
#undef Wft
#undef Wat
#undef Wot
#undef Wgut
#undef Wdt
#undef Wpgt
#undef Wppt
#undef Pb
#undef XN
#undef Yb
#undef X1b
#undef Qb
#undef Ob
#undef Kb
#undef MG
#undef VT
#undef PP
#undef ZT
#undef Hb
#undef XNp
#undef Gt
#undef T32
#undef KIN
extern "C" void kernel_launch(void* const* d_in, const int* in_sizes, int n_in, void* d_out, int out_size, void* d_ws, size_t ws_size, hipStream_t stream) {
    static int grid = 0;
    if (grid == 0) {
        if (n_in != 22 || in_sizes[0] != MTOK * DM || out_size != MTOK * DM || ws_size < WS_END) { fprintf(stderr, "kernel_launch: unexpected shapes / workspace (n_in %d, ws %zu)\n", n_in, ws_size); grid = -1; return; }
        int dev = 0, cus = 0, per_cu = 0;
        if (hipGetDevice(&dev) != hipSuccess || hipDeviceGetAttribute(&cus, hipDeviceAttributeMultiprocessorCount, dev) != hipSuccess) { grid = -1; return; }
        if (hipFuncSetAttribute((const void*)fwd_megakernel, hipFuncAttributeMaxDynamicSharedMemorySize, LDS_BYTES) != hipSuccess) { fprintf(stderr, "kernel_launch: hipFuncSetAttribute failed\n"); grid = -1; return; }
        if (hipOccupancyMaxActiveBlocksPerMultiprocessor(&per_cu, (const void*)fwd_megakernel, 512, LDS_BYTES) != hipSuccess || per_cu < 1) { fprintf(stderr, "kernel_launch: occupancy query failed (%d)\n", per_cu); (void)hipGetLastError(); per_cu = 1; }
        grid = cus * per_cu;
    }
    if (grid < 0) return;
    (void)hipMemsetAsync((char*)d_ws + WS_CTL, 0, CTL_ZERO_BYTES, stream);
    (void)hipMemsetAsync((char*)d_ws + WS_QN2, 0, NRM_ZERO_BYTES, stream);
    Args a{};
    for (int i = 0; i < 22; ++i) a.in[i] = (const float*)d_in[i];
    a.out = (float*)d_out; a.ws = (unsigned char*)d_ws;
    void* args[] = {&a};
    hipError_t e = hipLaunchCooperativeKernel((const void*)fwd_megakernel, dim3(grid), dim3(512), args, LDS_BYTES, stream);
    if (e != hipSuccess) fprintf(stderr, "cooperative launch failed: %s (grid %d)\n", hipGetErrorString(e), grid);
}
```

```cpp
#include <hip/hip_runtime.h>
#include <hip/hip_cooperative_groups.h>
#include <cstdio>
#include <cstdint>
namespace cg = cooperative_groups;
#ifndef PROBE_PHASE
#define PROBE_PHASE -1
#endif
#define PROBE_MULT 4
#define PH_BEGIN(k) unsigned long long t_ph0_##k = 0; if (PROBE_PHASE == (k)) t_ph0_##k = __builtin_amdgcn_s_memrealtime();
#define PH_END(k) if (PROBE_PHASE == (k)) { const unsigned long long t1_ = __builtin_amdgcn_s_memrealtime(), dt_ = t1_ - t_ph0_##k; while (__builtin_amdgcn_s_memrealtime() < t1_ + PROBE_MULT * dt_) __builtin_amdgcn_s_sleep(64); }
namespace pg8 {
#define PG8_LAS __attribute__((address_space(3)))
typedef unsigned short bf16_t;
typedef short bf16x8 __attribute__((ext_vector_type(8)));
typedef float f32x4 __attribute__((ext_vector_type(4)));
typedef unsigned u32x4 __attribute__((ext_vector_type(4)));
constexpr int BM = 256, BK = 64, HALF = 128, HTB = HALF * BK * 2  , STAGE_BYTES = 8 * HTB, NXCD = 8, WGM = 8;

__host__ __device__ __forceinline__ int lds_byte(int r, int c) { const int st = (r >> 4) * 2 + (c >> 5), rr = r & 15, cc = c & 31, ob = rr * 64 + cc * 2; return st * 1024 + (ob ^ (((ob >> 9) & 1) << 5)); }
__host__ __device__ __forceinline__ void stage_rc(int b, int& R, int& C) { const int st = b / 1024, sb = b % 1024, swz = sb ^ (((sb >> 9) & 1) << 5); R = (st >> 1) * 16 + swz / 64; C = (st & 1) * 32 + (swz % 64) / 2; }
__host__ __device__ __forceinline__ int perm32(int rho) { const int n = rho >> 4, i = rho & 15; return 8 * (i >> 2) + 4 * n + (i & 3); }

struct Unit { int pm, pn; };
struct Gemm { const bf16_t* A; const bf16_t* Bt; int M, N, K; };

struct StaticOrder {
    int nM, nN, nwg, G, c;
    __host__ __device__ void init(int M, int N, int G_, int c_) { nM = M / BM; nN = N / BM; nwg = nM * nN; G = G_; c = c_; }
    __host__ __device__ bool next(int i, Unit& u) const {
        const long L = (long)i * G + c; if (L >= nwg) return false;
        int wgid = (int)L; { const int q = nwg / NXCD, r = nwg % NXCD, xcd = wgid % NXCD, off = wgid / NXCD; wgid = (xcd < r ? xcd * (q + 1) : r * (q + 1) + (xcd - r) * q) + off; }
        const int nig = WGM * nN, gid = wgid / nig, fm = gid * WGM, gsz = (nM - fm) < WGM ? (nM - fm) : WGM;
        u.pm = fm + ((wgid % nig) % gsz); u.pn = (wgid % nig) / gsz; return true;
    }
    __device__ __forceinline__ void a_ready(const Unit&) const {}
    __device__ __forceinline__ void done(const Unit&) const {}
};

__device__ __forceinline__ unsigned cvt_pk_bf16(float lo, float hi) { unsigned r; asm volatile("v_cvt_pk_bf16_f32 %0, %1, %2" : "=v"(r) : "v"(lo), "v"(hi)); return r; }
typedef float f32x2 __attribute__((ext_vector_type(2)));

#define EPI_LOOP(...) \
  _Pragma("unroll") for (int ai = 0; ai < 2; ++ai) _Pragma("unroll") for (int m = 0; m < 4; ++m) _Pragma("unroll") for (int bj = 0; bj < 2; ++bj) { \
     const int row = u.pm * BM + ai * HALF + wr * 64 + m * 16 + fr; const int col = u.pn * BM + bj * HALF + wc * 32 + 8 * fq; \
     f32x4 v0 = acc[ai][bj][m][0], v1 = acc[ai][bj][m][1]; __VA_ARGS__ }
__device__ __forceinline__ u32x4 pack8(f32x4 v0, f32x4 v1) { u32x4 w; w.x = cvt_pk_bf16(v0[0], v0[1]); w.y = cvt_pk_bf16(v0[2], v0[3]); w.z = cvt_pk_bf16(v1[0], v1[1]); w.w = cvt_pk_bf16(v1[2], v1[3]); return w; }
__device__ __forceinline__ float bf_lo(unsigned w) { return __uint_as_float(w << 16); }
__device__ __forceinline__ float bf_hi(unsigned w) { return __uint_as_float(w & 0xffff0000u); }
__device__ __forceinline__ void unpack8(u32x4 w, f32x4& a, f32x4& b) { a = (f32x4){bf_lo(w.x), bf_hi(w.x), bf_lo(w.y), bf_hi(w.y)}; b = (f32x4){bf_lo(w.z), bf_hi(w.z), bf_lo(w.w), bf_hi(w.w)}; }
__device__ __forceinline__ float sigm(float x) { return __builtin_amdgcn_rcpf(1.0f + __expf(-x)); }
__device__ __forceinline__ f32x4 sigm4(f32x4 x) { return (f32x4){sigm(x[0]), sigm(x[1]), sigm(x[2]), sigm(x[3])}; }
__device__ __forceinline__ float sum8sq(f32x4 a, f32x4 b) { return (a[0] * a[0] + a[1] * a[1]) + (a[2] * a[2] + a[3] * a[3]) + (b[0] * b[0] + b[1] * b[1]) + (b[2] * b[2] + b[3] * b[3]); }

struct EpiQKG {
    static constexpr bool PERM = true, AFTER_DRAIN = false;
    bf16_t* Q; bf16_t* Kb; bf16_t* G; const float* bias; float qscale;
    __device__ __forceinline__ void operator()(const f32x4 (&acc)[2][2][4][2], const Unit& u, int wr, int wc, int fr, int fq) const {
        if (u.pn < 4) { EPI_LOOP( v0 = v0 * qscale; v1 = v1 * qscale; __builtin_nontemporal_store(pack8(v0, v1), (u32x4*)(Q + (size_t)row * 1024 + col));
                                  float sq = sum8sq(v0, v1); sq += __shfl_xor(sq, 16); sq += __shfl_xor(sq, 32);
                                  int rr = row; asm volatile("" : "+v"(rr)); if (fq == 0) __hip_atomic_fetch_add((float*)((char*)Q - (70ll << 20)) + (size_t)(col >> 6) * 32768 + rr, sq, __ATOMIC_RELAXED, __HIP_MEMORY_SCOPE_AGENT); __builtin_amdgcn_sched_barrier(0); ) }
        else if (u.pn < 8) { EPI_LOOP( __builtin_nontemporal_store(pack8(v0, v1), (u32x4*)(Kb + (size_t)row * 1024 + (col - 1024)));
                                  float sq = sum8sq(v0, v1); sq += __shfl_xor(sq, 16); sq += __shfl_xor(sq, 32);
                                  int rr = row; asm volatile("" : "+v"(rr)); if (fq == 0) __hip_atomic_fetch_add((float*)((char*)Q - (68ll << 20)) + (size_t)((col - 1024) >> 6) * 32768 + rr, sq, __ATOMIC_RELAXED, __HIP_MEMORY_SCOPE_AGENT); __builtin_amdgcn_sched_barrier(0); ) }
        else { EPI_LOOP( const int gc = col - 2048; const f32x4 b0 = *(const f32x4*)(bias + gc), b1 = *(const f32x4*)(bias + gc + 4);
                         __builtin_nontemporal_store(pack8(sigm4(v0 + b0), sigm4(v1 + b1)), (u32x4*)(G + (size_t)row * 2048 + gc)); ) }
    }
};
struct EpiZ4 {
    static constexpr bool PERM = true, AFTER_DRAIN = false;
    bf16_t* Z4;
    __device__ __forceinline__ void operator()(const f32x4 (&acc)[2][2][4][2], const Unit& u, int wr, int wc, int fr, int fq) const {
        EPI_LOOP( int part, c; if (row < 520) { const int g_ = row / 65; part = 0; c = g_ * 80 + (row - g_ * 65); } else { const int r_ = row - 520, g_ = r_ / 63; part = 1; c = g_ * 80 + (r_ - g_ * 63) + 1; }
                  const int b = col >> 12, s2 = (col >> 6) & 63, s1 = col & 63;
                  *(u32x4*)(Z4 + (((size_t)(b * 640 + c) * 64 + s2) * 128 + part * 64 + s1)) = pack8(v0, v1); )
    }
};
struct EpiVT {
    static constexpr bool PERM = true, AFTER_DRAIN = false;
    bf16_t* VT;
    __device__ __forceinline__ void operator()(const f32x4 (&acc)[2][2][4][2], const Unit& u, int wr, int wc, int fr, int fq) const {
        EPI_LOOP( const int b = col >> 12, s = col & 4095; __builtin_nontemporal_store(pack8(v0, v1), (u32x4*)(VT + ((size_t)(b * 1024 + row)) * 4096 + s)); )
    }
};
struct EpiG {
    static constexpr bool PERM = true, AFTER_DRAIN = false;
    const float* TW; bf16_t* Ga; bf16_t* Gb;
    __device__ __forceinline__ void operator()(const f32x4 (&acc)[2][2][4][2], const Unit& u, int wr, int wc, int fr, int fq) const {
#pragma unroll
        for (int a = 0; a < 2; ++a)
#pragma unroll
            for (int bj = 0; bj < 2; ++bj) {
                const int k1 = 32 * wr + 16 * a + fr, n = u.pn * BM + bj * HALF + wc * 32 + 8 * fq, s2 = n & 63, q_ = n >> 6, b = q_ / 640, c = q_ - b * 640;
                const f32x4 re0 = acc[0][bj][2 * a][0], re1 = acc[0][bj][2 * a][1], im0 = acc[0][bj][2 * a + 1][0], im1 = acc[0][bj][2 * a + 1][1];
                const f32x4* tw = (const f32x4*)(TW + (size_t)(k1 * 64 + s2) * 2);
                const f32x4 t0 = tw[0], t1 = tw[1], t2 = tw[2], t3 = tw[3];
                const f32x4 tr0 = {t0[0], t0[2], t1[0], t1[2]}, ti0 = {t0[1], t0[3], t1[1], t1[3]}, tr1 = {t2[0], t2[2], t3[0], t3[2]}, ti1 = {t2[1], t2[3], t3[1], t3[3]};
                bf16_t* base = (b < 4 ? Ga : Gb) + (((size_t)((b & 3) * 64 + k1) * 640 + c) * 128 + s2);
                *(u32x4*)(base) = pack8(re0 * tr0 - im0 * ti0, re1 * tr1 - im1 * ti1);
                *(u32x4*)(base + 64) = pack8(re0 * ti0 + im0 * tr0, re1 * ti1 + im1 * tr1);
            }
    }
};
struct EpiY3 {
    static constexpr bool PERM = true, AFTER_DRAIN = false;
    bf16_t* Y; int b0;
    __device__ __forceinline__ void operator()(const f32x4 (&acc)[2][2][4][2], const Unit& u, int wr, int wc, int fr, int fq) const {
        if (wr == 0) {
#pragma unroll
            for (int m = 0; m < 4; ++m)
#pragma unroll
                for (int bj = 0; bj < 2; ++bj) { const int k2 = 16 * m + fr, n = u.pn * BM + bj * HALF + wc * 32 + 8 * fq, t_ = n / 640, cp = n - t_ * 640, k1 = t_ & 63, bl = t_ >> 6, g = cp / 80, m0 = cp - g * 80;
                    const int k = k1 + 64 * k2, b = b0 + bl;
                    const u32x4 w = pack8(acc[0][bj][m][0], acc[0][bj][m][1]);
                    bf16_t* yrow = Y + ((size_t)(b * 4096 + k)) * 1024 + g * 128;
                    if (m0 < 64) {
                        *(u32x4*)(yrow + m0) = w;
                        bf16_t* ymir = Y + ((size_t)(b * 4096 + ((4096 - k) & 4095))) * 1024 + g * 128 + 128 - m0;
                        const unsigned ww[4] = {w.x, w.y, w.z, w.w};
#pragma unroll
                        for (int e = 0; e < 8; ++e) { const bf16_t v = (bf16_t)((e & 1) ? (ww[e >> 1] >> 16) : (ww[e >> 1] & 0xffffu)); if (e > 0 || m0 > 0) ymir[-e] = v; }
                    } else if (m0 == 64) yrow[64] = (bf16_t)(w.x & 0xffffu);
                }
        }
    }
};
struct EpiPlain {
    static constexpr bool PERM = true, AFTER_DRAIN = false;
    bf16_t* O; int ldc;
    __device__ __forceinline__ void operator()(const f32x4 (&acc)[2][2][4][2], const Unit& u, int wr, int wc, int fr, int fq) const {
        EPI_LOOP( __builtin_nontemporal_store(pack8(v0, v1), (u32x4*)(O + (size_t)row * ldc + col)); )
    }
};
struct EpiGateF {
    static constexpr bool PERM = true, AFTER_DRAIN = false;
    const bf16_t* G; bf16_t* T32;
    __device__ __forceinline__ void operator()(const f32x4 (&acc)[2][2][4][2], const Unit& u, int wr, int wc, int fr, int fq) const {
        EPI_LOOP( f32x4 g0, g1; unpack8(*(const u32x4*)(G + (size_t)row * 2048 + col), g0, g1);
                  *(u32x4*)(T32 + (size_t)row * 1024 + col) = pack8(g0 * v0, g1 * v1); )
    }
};
struct EpiGateA {
    static constexpr bool PERM = true, AFTER_DRAIN = false;
    const bf16_t* G; const bf16_t* T32; bf16_t* MG;
    __device__ __forceinline__ void operator()(const f32x4 (&acc)[2][2][4][2], const Unit& u, int wr, int wc, int fr, int fq) const {
        EPI_LOOP( f32x4 g0, g1; unpack8(*(const u32x4*)(G + (size_t)row * 2048 + 1024 + col), g0, g1);
                  f32x4 t0, t1; unpack8(*(const u32x4*)(T32 + (size_t)row * 1024 + col), t0, t1);
                  *(u32x4*)(MG + (size_t)row * 1024 + col) = pack8(t0 + g0 * v0, t1 + g1 * v1); )
    }
};
template <bool BASE_BF16> struct EpiResid {
    static constexpr bool PERM = true, AFTER_DRAIN = false;
    const void* base; bf16_t* outb; float* ss;
    __device__ __forceinline__ void operator()(const f32x4 (&acc)[2][2][4][2], const Unit& u, int wr, int wc, int fr, int fq) const {
#pragma unroll
        for (int ai = 0; ai < 2; ++ai)
#pragma unroll
            for (int m = 0; m < 4; ++m) { const int row = u.pm * BM + ai * HALF + wr * 64 + m * 16 + fr; float sq = 0.f;
#pragma unroll
                for (int bj = 0; bj < 2; ++bj) { const int col = u.pn * BM + bj * HALF + wc * 32 + 8 * fq; const size_t off = (size_t)row * 1024 + col;
                    f32x4 b0, b1;
                    if (BASE_BF16) unpack8(*(const u32x4*)((const bf16_t*)base + off), b0, b1); else { b0 = *(const f32x4*)((const float*)base + off); b1 = *(const f32x4*)((const float*)base + off + 4); }
                    const f32x4 x0 = b0 + acc[ai][bj][m][0], x1 = b1 + acc[ai][bj][m][1];
                    *(u32x4*)(outb + off) = pack8(x0, x1); sq += sum8sq(x0, x1); }
                sq += __shfl_xor(sq, 16); sq += __shfl_xor(sq, 32);
                if (fq == 0) __hip_atomic_fetch_add(ss + row, sq, __ATOMIC_RELAXED, __HIP_MEMORY_SCOPE_AGENT); }
    }
};
struct EpiSwiGLU {
    static constexpr bool PERM = true, AFTER_DRAIN = false;
    const float* ss; bf16_t* H;
    __device__ __forceinline__ void operator()(const f32x4 (&acc)[2][2][4][2], const Unit& u, int wr, int wc, int fr, int fq) const {
#pragma unroll
        for (int ai = 0; ai < 2; ++ai)
#pragma unroll
            for (int m = 0; m < 4; ++m) { const int row = u.pm * BM + ai * HALF + wr * 64 + m * 16 + fr, f0 = u.pn * HALF + wc * 32 + 8 * fq;
                const float rs = __builtin_amdgcn_rsqf(ss[row] * (1.0f / 1024.0f) + 1e-6f);
                const f32x4 g0 = acc[ai][0][m][0] * rs, g1 = acc[ai][0][m][1] * rs, u0 = acc[ai][1][m][0] * rs, u1 = acc[ai][1][m][1] * rs;
                *(u32x4*)(H + (size_t)row * 2816 + f0) = pack8(g0 * sigm4(g0) * u0, g1 * sigm4(g1) * u1); }
    }
};
struct EpiPle {
    static constexpr bool PERM = true, AFTER_DRAIN = false;
    const float* ss2; const bf16_t* PP; const bf16_t* x; bf16_t* X3b; float* ss3;
    __device__ __forceinline__ void operator()(const f32x4 (&acc)[2][2][4][2], const Unit& u, int wr, int wc, int fr, int fq) const {
#pragma unroll
        for (int ai = 0; ai < 2; ++ai)
#pragma unroll
            for (int m = 0; m < 4; ++m) { const int row = u.pm * BM + ai * HALF + wr * 64 + m * 16 + fr; float sq = 0.f;
                const float rs = __builtin_amdgcn_rsqf(ss2[row] * (1.0f / 1024.0f) + 1e-6f);
#pragma unroll
                for (int bj = 0; bj < 2; ++bj) { const int col = u.pn * BM + bj * HALF + wc * 32 + 8 * fq; const size_t off = (size_t)row * 1024 + col;
                    f32x4 p0, p1; unpack8(*(const u32x4*)(PP + off), p0, p1);
                    f32x4 xb0, xb1; unpack8(*(const u32x4*)(x + off), xb0, xb1);
                    const f32x4 x0 = xb0 + sigm4(acc[ai][bj][m][0] * rs) * p0, x1 = xb1 + sigm4(acc[ai][bj][m][1] * rs) * p1;
                    *(u32x4*)(X3b + off) = pack8(x0, x1); sq += sum8sq(x0, x1); }
                sq += __shfl_xor(sq, 16); sq += __shfl_xor(sq, 32);
                if (fq == 0) __hip_atomic_fetch_add(ss3 + row, sq, __ATOMIC_RELAXED, __HIP_MEMORY_SCOPE_AGENT); }
    }
};
template <class Epi, class Sched, bool ALIGN_EPI = false, bool SP2 = false>
__device__ __forceinline__ void gemm_phase(PG8_LAS unsigned char* lds, const Gemm g, const Sched& S, const Epi& E) {
    int tid_ = threadIdx.x; asm volatile("" : "+v"(tid_));
    const int tid = tid_, wid = __builtin_amdgcn_readfirstlane(tid >> 6), lane = tid & 63, wr = wid >> 2, wc = wid & 3, fr = lane & 15, fq = lane >> 4;
    const int K = g.K, nt = K / BK;
    unsigned voffA[2], voffB[2];
#pragma unroll
    for (int i = 0; i < 2; ++i) { int R, C; stage_rc(tid * 16 + i * 8192, R, C); const int Rb = Epi::PERM ? ((R & ~31) + perm32(R & 31)) : R;
        voffA[i] = (unsigned)(R * K + C) * 2u; voffB[i] = (unsigned)(Rb * K + C) * 2u; }
    const size_t kstep = (size_t)(BK * 2);
    const size_t hstep = (size_t)HALF * K * 2;
    const size_t tstep = 2 * hstep;
    const unsigned ldsw = (unsigned)wid * 1024u;
    const int aoff = lds_byte(wr * 64 + fr, fq * 8), boff = lds_byte(wc * 32 + fr, fq * 8);
#define PG8_SA(b, h) (((b) * 2 + (h)) * HTB)
#define PG8_SB(b, h) ((4 + (b) * 2 + (h)) * HTB)
#define PG8_STAGE(bufoff, gbase, voff) do { _Pragma("unroll") for (int _i = 0; _i < 2; ++_i) \
        __builtin_amdgcn_global_load_lds((const unsigned*)((const char*)(gbase) + (voff)[_i]), (PG8_LAS unsigned*)(lds + (bufoff) + ldsw + _i * 8192), 16, 0, 0); } while (0)
#define PG8_LDA(dst, b, h) do { _Pragma("unroll") for (int m = 0; m < 4; ++m) _Pragma("unroll") for (int k = 0; k < 2; ++k) dst[m][k] = *(const PG8_LAS bf16x8*)(lds + PG8_SA(b, h) + aoff + m * 2048 + k * 1024); } while (0)
#define PG8_LDB(dst, b, h) do { _Pragma("unroll") for (int n = 0; n < 2; ++n) _Pragma("unroll") for (int k = 0; k < 2; ++k) dst[n][k] = *(const PG8_LAS bf16x8*)(lds + PG8_SB(b, h) + boff + n * 2048 + k * 1024); } while (0)
#define PG8_MMA(ai, bj, At, Bt) do { __builtin_amdgcn_s_setprio(1); _Pragma("unroll") for (int m = 0; m < 4; ++m) _Pragma("unroll") for (int n = 0; n < 2; ++n) _Pragma("unroll") for (int k = 0; k < 2; ++k) \
        acc[ai][bj][m][n] = __builtin_amdgcn_mfma_f32_16x16x32_bf16(Bt[n][k], At[m][k], acc[ai][bj][m][n], 0, 0, 0); __builtin_amdgcn_s_setprio(0); } while (0)
#define PG8_WAIT_V(n) asm volatile("s_waitcnt vmcnt(" #n ")" ::: "memory")
#define PG8_WAIT_L(n) asm volatile("s_waitcnt lgkmcnt(" #n ")" ::: "memory")
#define PG8_BAR __builtin_amdgcn_s_barrier()
#define PG8_SCHED __builtin_amdgcn_sched_barrier(0)
    Unit cur, nxt; int ui = 0;
    if (!S.next(0, cur)) return;
    f32x4 acc[2][2][4][2];
#pragma unroll
    for (int a = 0; a < 2; ++a)
#pragma unroll
        for (int b = 0; b < 2; ++b)
#pragma unroll
            for (int m = 0; m < 4; ++m)
#pragma unroll
                for (int n = 0; n < 2; ++n) acc[a][b][m][n] = (f32x4){0.f, 0.f, 0.f, 0.f};
    bf16x8 At[4][2], B0[2][2], B1[2][2];
    const char* cA = (const char*)g.A + (size_t)cur.pm * tstep; const char* cB = (const char*)g.Bt + (size_t)cur.pn * tstep;
    S.a_ready(cur);
    if constexpr (SP2) {
        PG8_STAGE(PG8_SB(0, 0), cB, voffB); PG8_STAGE(PG8_SB(0, 1), cB + hstep, voffB); PG8_STAGE(PG8_SA(0, 0), cA, voffA); PG8_STAGE(PG8_SA(0, 1), cA + hstep, voffA);
        if (wr == 1) PG8_BAR;
        PG8_WAIT_V(2); PG8_BAR;
        PG8_STAGE(PG8_SB(1, 0), cB + kstep, voffB); PG8_STAGE(PG8_SA(1, 0), cA + kstep, voffA); PG8_STAGE(PG8_SB(1, 1), cB + hstep + kstep, voffB);
        PG8_WAIT_V(6); PG8_BAR;
    } else {
        PG8_STAGE(PG8_SB(0, 0), cB, voffB); PG8_STAGE(PG8_SA(0, 0), cA, voffA); PG8_STAGE(PG8_SB(0, 1), cB + hstep, voffB); PG8_STAGE(PG8_SA(0, 1), cA + hstep, voffA);
        if (wr == 1) PG8_BAR;
        PG8_WAIT_V(4); PG8_BAR;
        PG8_STAGE(PG8_SB(1, 0), cB + kstep, voffB); PG8_STAGE(PG8_SA(1, 0), cA + kstep, voffA); PG8_STAGE(PG8_SB(1, 1), cB + hstep + kstep, voffB);
        PG8_WAIT_V(6); PG8_BAR;
    }
    for (;;) {
        const bool has_next = S.next(ui + 1, nxt);
        const char* nA = has_next ? (const char*)g.A + (size_t)nxt.pm * tstep : cA; const char* nB = has_next ? (const char*)g.Bt + (size_t)nxt.pn * tstep : cB;
        for (int t = 0; t < nt; t += 2) {
            const bool last = (t == nt - 2);
            const char* a1 = cA + (size_t)(t + 1) * kstep;
            const char* a2 = last ? nA : cA + (size_t)(t + 2) * kstep; const char* b2 = last ? nB : cB + (size_t)(t + 2) * kstep;
            const char* a3 = a2 + kstep; const char* b3 = b2 + kstep;
            if (last && has_next) S.a_ready(nxt);
            if constexpr (SP2) {
            PG8_LDB(B0, 0, 0); PG8_LDB(B1, 0, 1); PG8_SCHED; PG8_LDA(At, 0, 0); PG8_STAGE(PG8_SA(1, 1), a1 + hstep, voffA);
            PG8_WAIT_V(8); PG8_WAIT_L(0); PG8_BAR; PG8_MMA(0, 0, At, B0); PG8_MMA(0, 1, At, B1); PG8_BAR; PG8_SCHED;
            PG8_LDA(At, 0, 1); PG8_STAGE(PG8_SB(0, 0), b2, voffB); PG8_STAGE(PG8_SB(0, 1), b2 + hstep, voffB); PG8_STAGE(PG8_SA(0, 0), a2, voffA);
            PG8_WAIT_V(8); PG8_WAIT_L(0); PG8_BAR; PG8_MMA(1, 0, At, B0); PG8_MMA(1, 1, At, B1); PG8_BAR; PG8_SCHED;
            PG8_LDB(B0, 1, 0); PG8_LDB(B1, 1, 1); PG8_SCHED; PG8_LDA(At, 1, 0); PG8_STAGE(PG8_SA(0, 1), a2 + hstep, voffA);
            PG8_WAIT_V(8); PG8_WAIT_L(0); PG8_BAR; PG8_MMA(0, 0, At, B0); PG8_MMA(0, 1, At, B1); PG8_BAR; PG8_SCHED;
            PG8_LDA(At, 1, 1); PG8_STAGE(PG8_SB(1, 0), b3, voffB); PG8_STAGE(PG8_SB(1, 1), b3 + hstep, voffB); PG8_STAGE(PG8_SA(1, 0), a3, voffA);
            PG8_WAIT_V(8); PG8_WAIT_L(0); PG8_BAR; PG8_MMA(1, 0, At, B0); PG8_MMA(1, 1, At, B1); PG8_BAR; PG8_SCHED;
            } else {
            PG8_LDB(B0, 0, 0); PG8_SCHED; PG8_LDA(At, 0, 0); PG8_STAGE(PG8_SA(1, 1), a1 + hstep, voffA);
            PG8_WAIT_L(8); PG8_BAR; PG8_WAIT_L(0); PG8_MMA(0, 0, At, B0); PG8_BAR; PG8_SCHED;
            PG8_LDB(B1, 0, 1); PG8_STAGE(PG8_SB(0, 0), b2, voffB);
            PG8_BAR; PG8_WAIT_L(0); PG8_MMA(0, 1, At, B1); PG8_BAR;
            PG8_LDA(At, 0, 1); PG8_STAGE(PG8_SA(0, 0), a2, voffA);
            PG8_BAR; PG8_WAIT_L(0); PG8_MMA(1, 0, At, B0); PG8_BAR; PG8_SCHED;
            PG8_STAGE(PG8_SB(0, 1), b2 + hstep, voffB);
            PG8_WAIT_V(6); PG8_BAR; PG8_MMA(1, 1, At, B1); PG8_BAR;
            PG8_LDB(B0, 1, 0); PG8_SCHED; PG8_LDA(At, 1, 0); PG8_STAGE(PG8_SA(0, 1), a2 + hstep, voffA);
            PG8_WAIT_L(8); PG8_BAR; PG8_WAIT_L(0); PG8_MMA(0, 0, At, B0); PG8_BAR; PG8_SCHED;
            PG8_LDB(B1, 1, 1); PG8_STAGE(PG8_SB(1, 0), b3, voffB);
            PG8_BAR; PG8_WAIT_L(0); PG8_MMA(0, 1, At, B1); PG8_BAR;
            PG8_LDA(At, 1, 1); PG8_STAGE(PG8_SA(1, 0), a3, voffA);
            PG8_BAR; PG8_WAIT_L(0); PG8_MMA(1, 0, At, B0); PG8_BAR; PG8_SCHED;
            PG8_STAGE(PG8_SB(1, 1), b3 + hstep, voffB);
            PG8_WAIT_V(6); PG8_BAR; PG8_MMA(1, 1, At, B1); PG8_BAR;
            }
        }
        if constexpr (ALIGN_EPI) { if (wr == 0) PG8_BAR; }
        if constexpr (!Epi::AFTER_DRAIN) { E(acc, cur, wr, wc, fr, fq); S.done(cur); }
        if (!has_next) break;
#pragma unroll
        for (int a = 0; a < 2; ++a)
#pragma unroll
            for (int b = 0; b < 2; ++b)
#pragma unroll
                for (int m = 0; m < 4; ++m)
#pragma unroll
                    for (int n = 0; n < 2; ++n) acc[a][b][m][n] = (f32x4){0.f, 0.f, 0.f, 0.f};
        cur = nxt; cA = nA; cB = nB; ++ui;
        if constexpr (ALIGN_EPI) { if (wr == 1) PG8_BAR; }
    }
    PG8_WAIT_V(0);
    if constexpr (!ALIGN_EPI) { if (wr == 0) PG8_BAR; }
    PG8_BAR;
    if constexpr (Epi::AFTER_DRAIN) { E.fused(acc, cur, wr, wc, fr, fq, lds, wid, lane); S.done(cur); }
#undef PG8_SA
#undef PG8_SB
#undef PG8_STAGE
#undef PG8_LDA
#undef PG8_LDB
#undef PG8_MMA
#undef PG8_WAIT_V
#undef PG8_WAIT_L
#undef PG8_BAR
#undef PG8_SCHED
}
}

#define LAS __attribute__((address_space(3)))
typedef unsigned short bf16;
typedef unsigned v4u __attribute__((ext_vector_type(4)));
typedef unsigned v2u __attribute__((ext_vector_type(2)));
typedef float f32x4 __attribute__((ext_vector_type(4)));
typedef short bf16x8 __attribute__((ext_vector_type(8)));
typedef float f32x16 __attribute__((ext_vector_type(16)));
constexpr int MTOK = 32768, DM = 1024, SEQ = 4096, NB = 8, NH = 8, DFF = 2816, PLE = 256;
constexpr size_t MiB = 1u << 20;
constexpr size_t WS_CTL = 0, CTL_ZERO_BYTES = 1 * MiB;
constexpr size_t WS_W1T = 1 * MiB, WS_W2T = 9 * MiB, WS_WFT = 15 * MiB, WS_WAT = 17 * MiB, WS_WOT = 19 * MiB, WS_WGUT = 21 * MiB, WS_WDT = 32 * MiB, WS_WPGT = 38 * MiB, WS_WPPT = 40 * MiB, WS_PB = 41 * MiB;
constexpr size_t WS_QN2 = 58 * MiB, WS_KN2 = 60 * MiB, NRM_ZERO_BYTES = 4 * MiB;
constexpr size_t WS_XN = 64 * MiB;
constexpr size_t WS_Q = 128 * MiB; static_assert(WS_Q - WS_QN2 == (70ull << 20) && WS_Q - WS_KN2 == (68ull << 20), "EpiQKG derives the norm arrays from Q");
constexpr size_t WS_K = 192 * MiB;
constexpr size_t WS_VT = 256 * MiB;
constexpr size_t WS_ZT = 320 * MiB;
constexpr size_t WS_DM = 448 * MiB;
constexpr size_t WS_F1 = 57 * MiB, WS_F3 = 57 * MiB + 65536, WS_TW = 57 * MiB + 131072; static_assert(WS_PB + (size_t)MTOK * PLE * 2 <= WS_F1 && WS_TW + 32768 <= WS_QN2, "constants sit between Pb and the norm arrays");
constexpr size_t WS_T32 = 384 * MiB;
constexpr size_t WS_END = 512 * MiB;
constexpr int LDS_BYTES = 131072 + 512;
constexpr int LDS_XB_OFF = 131072 + 256;
constexpr size_t WS_XBAR = 512 * 1024;
constexpr float LOG2E = 1.4426950408889634f;

__device__ __forceinline__ unsigned f2bf(float f) { unsigned u = __builtin_bit_cast(unsigned, f); return (u + 0x7fffu + ((u >> 16) & 1u)) >> 16; }
__device__ __forceinline__ unsigned pk2(float lo, float hi) { return f2bf(lo) | (f2bf(hi) << 16); }
__device__ __forceinline__ float wave_sum(float v) {
#pragma unroll
    for (int o = 1; o < 64; o <<= 1) v += __shfl_xor(v, o);
    return v;
}


typedef __attribute__((address_space(1))) unsigned gu32;
#define XB_TMO      128
#define XB_XCNT(j)  (256  + 64 * (j))
#define XB_XSUB(j)  (1280 + 64 * (j))
#define XB_XGEN(j)  (2304 + 64 * (j))
#define XB_TOP      3328
#define XB_TOPGEN   3392
#define XCD_BAR_WORDS 3456
#define XB_SPIN_CAP (1u << 18)

__device__ __forceinline__ unsigned xb_ld(unsigned* p)              { return __hip_atomic_load(p, __ATOMIC_RELAXED, __HIP_MEMORY_SCOPE_AGENT); }
__device__ __forceinline__ unsigned xb_add(unsigned* p, unsigned v) { return __hip_atomic_fetch_add(p, v, __ATOMIC_RELAXED, __HIP_MEMORY_SCOPE_AGENT); }
__device__ __forceinline__ unsigned xb_xcc_id() { return (unsigned)__builtin_amdgcn_s_getreg((3 << 11) | 20) & 0xFu; }
#define XB_SPIN(cond, bar) do { unsigned _sp = 0; while (cond) { __builtin_amdgcn_s_sleep(1); \
    if ((++_sp & 255u) == 0u) { if (xb_ld(&(bar)[XB_TMO])) break; if (_sp > XB_SPIN_CAP) { atomicAdd(&(bar)[XB_TMO], 1u); break; } } } } while (0)

struct XcdBarrier {
    unsigned* bar; unsigned x;
    volatile LAS unsigned* st;
};

__device__ __forceinline__ XcdBarrier xcd_barrier_post(unsigned* bar, volatile LAS unsigned* st) {
    XcdBarrier b; b.bar = bar; b.x = xb_xcc_id(); b.st = st;
    if (threadIdx.x == 0) (void)xb_add(&bar[XB_XCNT(b.x)], 1u);
    return b;
}
__device__ __forceinline__ void xcd_barrier_complete(unsigned* bar, unsigned x, unsigned& nloc, unsigned& nx) {
    const unsigned G = gridDim.x * gridDim.y * gridDim.z;
    unsigned sum, cnt, mine, sp = 0u;
    for (;;) {
        sum = 0u; cnt = 0u; mine = 0u;
#pragma unroll
        for (unsigned j = 0; j < 16; ++j) { const unsigned c = xb_ld(&bar[XB_XCNT(j)]); sum += c; cnt += (c > 0u) ? 1u : 0u; mine = (j == x) ? c : mine; }
        if (sum == G) break;
        __builtin_amdgcn_s_sleep(1);
        if ((++sp & 255u) == 0u) { if (xb_ld(&bar[XB_TMO])) break; if (sp > XB_SPIN_CAP) { atomicAdd(&bar[XB_TMO], 1u); break; } }
    }
    nloc = mine > 0u ? mine : 1u; nx = cnt > 0u ? cnt : 1u;
}

__device__ __forceinline__ void xcd_barrier(const XcdBarrier& b) {
    asm volatile("s_waitcnt vmcnt(0)" ::: "memory");
    __syncthreads();
    if (threadIdx.x == 0) {
        unsigned* bar = b.bar;
        __builtin_amdgcn_s_waitcnt(0);
        unsigned nloc = b.st[0], nx = b.st[1];
        if (nloc == 0u) { xcd_barrier_complete(bar, b.x, nloc, nx); b.st[0] = nloc; b.st[1] = nx; }
        const unsigned old = xb_add(&bar[XB_XSUB(b.x)], 1u);
        const unsigned gen = old / nloc;
        if (old + 1u == (gen + 1u) * nloc) {
            __builtin_amdgcn_fence(__ATOMIC_RELEASE, "agent");
            asm volatile("s_waitcnt vmcnt(0)" ::: "memory");
            const unsigned og = xb_add(&bar[XB_TOP], 1u);
            const unsigned tg = og / nx;
            if (og + 1u == (tg + 1u) * nx) xb_add(&bar[XB_TOPGEN], 1u);
            else XB_SPIN(xb_ld(&bar[XB_TOPGEN]) == tg, bar);
            __builtin_amdgcn_fence(__ATOMIC_ACQUIRE, "agent");
            xb_add(&bar[XB_XGEN(b.x)], 1u);
            asm volatile("s_waitcnt vmcnt(0)" ::: "memory");
        } else {
            XB_SPIN(xb_ld(&bar[XB_XGEN(b.x)]) == gen, bar);
            __builtin_amdgcn_fence(__ATOMIC_ACQUIRE, "agent");
            asm volatile("s_waitcnt vmcnt(0)" ::: "memory");
        }
    }
    __syncthreads();
}

namespace da {
constexpr int KROW = 272, VROW = 144, KT_BYTES = 64 * KROW, VT_BYTES = 128 * VROW, STG = KT_BYTES + VT_BYTES, EXROW = 33;
static_assert(4 * 128 * EXROW * 4 <= 2 * STG && 2 * STG + 128 <= 131072, "attention LDS");
__device__ __forceinline__ unsigned cvtpk(float lo, float hi) { unsigned r; asm volatile("v_cvt_pk_bf16_f32 %0, %1, %2" : "=v"(r) : "v"(lo), "v"(hi)); return r; }
__device__ __forceinline__ bf16x8 pack8f(const f32x16& p, int b) { v4u w; w.x = cvtpk(p[b], p[b + 1]); w.y = cvtpk(p[b + 2], p[b + 3]); w.z = cvtpk(p[b + 4], p[b + 5]); w.w = cvtpk(p[b + 6], p[b + 7]); return __builtin_bit_cast(bf16x8, w); }

__device__ __forceinline__ void attn_unit(LAS unsigned char* lds, int b, int h, int qb, const bf16* Q, const bf16* __restrict__ K, const bf16* __restrict__ VT, bf16* O, float lam, const float* __restrict__ gsub, const float* __restrict__ QN2, const float* __restrict__ KN2) {
    int tid_ = threadIdx.x; asm volatile("" : "+v"(tid_));
    const int tid = tid_, lane = tid & 63, r32 = lane & 31, hi = lane >> 5; const int wid = __builtin_amdgcn_readfirstlane(tid >> 6), c = wid & 1, sub = wid >> 1;
    const int q0 = qb * 128, qrow = q0 + sub * 32 + r32, t0 = q0 >> 6;
    const float sl2 = __builtin_amdgcn_exp2f(-(float)(h + 1)) * LOG2E;
    bf16x8 qf[4];
    { const bf16* qp = Q + ((size_t)b * SEQ + qrow) * DM + h * 128 + c * 64 + hi * 8;
#pragma unroll
      for (int d0 = 0; d0 < 4; ++d0) qf[d0] = *(const bf16x8*)(qp + d0 * 16); }
    const bf16* Kg = K + (size_t)b * SEQ * DM + h * 128 + (size_t)(tid >> 4) * DM + (tid & 15) * 8;
    const bf16* Vg = VT + ((size_t)(b * NH + h) * 128 + (tid >> 3)) * SEQ + (tid & 7) * 8;
    const int kst = (tid >> 4) * KROW + (tid & 15) * 16, vst = (tid >> 3) * VROW + (tid & 7) * 16;
    const int sw = (r32 & ~12) | ((r32 & 4) << 1) | ((r32 & 8) >> 1);
    const int krd = sw * KROW + c * 128 + hi * 16, vrd = r32 * VROW + hi * 16;
    v4u pre[4];
#define DA_LOADK(t) do { const int kv0_ = (t) * 64; pre[0] = *(const v4u*)(Kg + (size_t)kv0_ * DM); pre[1] = *(const v4u*)(Kg + (size_t)(kv0_ + 32) * DM); } while (0)
#define DA_LOADV(t) do { const int kv0_ = (t) * 64; pre[2] = *(const v4u*)(Vg + kv0_); pre[3] = *(const v4u*)(Vg + (size_t)64 * SEQ + kv0_); } while (0)
#define DA_STOREK(kbuf) do { LAS unsigned char* s_ = lds + (kbuf) * KT_BYTES + kst; *(LAS v4u*)(s_) = pre[0]; *(LAS v4u*)(s_ + 32 * KROW) = pre[1]; } while (0)
#define DA_STOREV(vbuf) do { LAS unsigned char* s_ = lds + 2 * KT_BYTES + (vbuf) * VT_BYTES + vst; *(LAS v4u*)(s_) = pre[2]; *(LAS v4u*)(s_ + 64 * VROW) = pre[3]; } while (0)
    int t_lo, nt;
    {
        float k0m = 0.f, k1m = 0.f, q0m = 0.f, q1m = 0.f;
        { const f32x4* kn0 = (const f32x4*)(KN2 + (size_t)(2 * h) * 32768 + (size_t)b * SEQ) + tid * 2; const f32x4* kn1 = kn0 + 32768 / 4;
          const f32x4 a0 = kn0[0], a1 = kn0[1], b0 = kn1[0], b1 = kn1[1];
          k0m = __builtin_fmaxf(__builtin_fmaxf(__builtin_fmaxf(a0[0], a0[1]), __builtin_fmaxf(a0[2], a0[3])), __builtin_fmaxf(__builtin_fmaxf(a1[0], a1[1]), __builtin_fmaxf(a1[2], a1[3])));
          k1m = __builtin_fmaxf(__builtin_fmaxf(__builtin_fmaxf(b0[0], b0[1]), __builtin_fmaxf(b0[2], b0[3])), __builtin_fmaxf(__builtin_fmaxf(b1[0], b1[1]), __builtin_fmaxf(b1[2], b1[3]))); }
        if (tid < 128) { const float* qn = QN2 + (size_t)(2 * h) * 32768 + (size_t)b * SEQ + q0 + tid; q0m = qn[0]; q1m = qn[32768]; }
        float dmin;
        { const bf16* kp = K + ((size_t)b * SEQ + qrow) * DM + h * 128 + c * 64 + hi * 8; float sp = 0.f;
#pragma unroll
          for (int d0 = 0; d0 < 4; ++d0) { const bf16x8 kd = *(const bf16x8*)(kp + d0 * 16);
#pragma unroll
              for (int j2 = 0; j2 < 8; ++j2) sp += __uint_as_float((unsigned)(unsigned short)qf[d0][j2] << 16) * __uint_as_float((unsigned)(unsigned short)kd[j2] << 16); }
          sp += __shfl_xor(sp, 32); dmin = sp;
#pragma unroll
          for (int o_ = 1; o_ < 32; o_ <<= 1) dmin = __builtin_fminf(dmin, __shfl_xor(dmin, o_)); }
#pragma unroll
        for (int o_ = 1; o_ < 64; o_ <<= 1) { k0m = __builtin_fmaxf(k0m, __shfl_xor(k0m, o_)); k1m = __builtin_fmaxf(k1m, __shfl_xor(k1m, o_)); q0m = __builtin_fmaxf(q0m, __shfl_xor(q0m, o_)); q1m = __builtin_fmaxf(q1m, __shfl_xor(q1m, o_)); }
        LAS float* red = (LAS float*)(lds + 2 * STG);
        if (lane == 0) { red[wid * 4 + 0] = k0m; red[wid * 4 + 1] = k1m; red[wid * 4 + 2] = q0m; red[wid * 4 + 3] = q1m; red[32 + wid] = dmin; }
        __syncthreads();
        k0m = 0.f; k1m = 0.f; q0m = 0.f; q1m = 0.f;
#pragma unroll
        for (int w_ = 0; w_ < 8; ++w_) { k0m = __builtin_fmaxf(k0m, red[w_ * 4 + 0]); k1m = __builtin_fmaxf(k1m, red[w_ * 4 + 1]); q0m = __builtin_fmaxf(q0m, red[w_ * 4 + 2]); q1m = __builtin_fmaxf(q1m, red[w_ * 4 + 3]); }
        const float Bq = 1.02f * __builtin_fmaxf(__builtin_sqrtf(k0m * q0m), __builtin_sqrtf(k1m * q1m));
        float dm = red[32];
#pragma unroll
        for (int w_ = 1; w_ < 8; ++w_) dm = __builtin_fminf(dm, red[32 + w_]);
        dm = __builtin_fmaxf(dm - 0.25f, -Bq);
        const float Rf = (Bq - dm + 40.f) / sl2;
        const int R = Rf < 8192.f ? (int)Rf + 1 : 8192;
        int lo = (q0 - 63 - R); lo = lo <= 0 ? 0 : (lo + 63) >> 6; int hi_t = (q0 + 127 + R) >> 6; hi_t = hi_t > 63 ? 63 : hi_t;
        t_lo = __builtin_amdgcn_readfirstlane(lo); nt = __builtin_amdgcn_readfirstlane(hi_t - lo + 1);
    }
    f32x16 o[4];
#pragma unroll
    for (int i = 0; i < 4; ++i)
#pragma unroll
        for (int r = 0; r < 16; ++r) o[i][r] = 0.f;
    float mref = 0.f;
    float lsum = 0.f;
#define DA_TILE(j_) (t_lo + (((t0 - t_lo) + (j_)) >= nt ? ((t0 - t_lo) + (j_)) - nt : ((t0 - t_lo) + (j_))))
    const float qposf = (float)(qrow - 8 * hi);
    const int grp = wid >> 2;
#define DA_BAR() do { asm volatile("s_waitcnt lgkmcnt(0)" ::: "memory"); __builtin_amdgcn_s_barrier(); asm volatile("" ::: "memory"); } while (0)
#define DA_CINIT(tn) do { const int tn_ = (tn); const float dln_ = qposf - (float)(tn_ * 64); \
        if (tn_ < t0 || tn_ > t0 + 1) { const float ss_ = (tn_ < t0) ? sl2 : -sl2; const float base_ = -ss_ * dln_ - mref; \
            _Pragma("unroll") for (int r = 0; r < 16; ++r) { const float cr = (float)((r & 7) + 16 * (r >> 3)); p0[r] = __builtin_fmaf(cr, ss_, base_); p1[r] = __builtin_fmaf(cr + 32.f, ss_, base_); } } \
        else { _Pragma("unroll") for (int r = 0; r < 16; ++r) { const float cr = (float)((r & 7) + 16 * (r >> 3)); \
            p0[r] = __builtin_fmaf(-sl2, __builtin_fabsf(dln_ - cr), -mref); p1[r] = __builtin_fmaf(-sl2, __builtin_fabsf(dln_ - (cr + 32.f)), -mref); } } } while (0)
#define DA_QK(kbuf) do { const LAS unsigned char* kb_ = lds + (kbuf) * KT_BYTES + krd; \
        _Pragma("unroll") for (int d0 = 0; d0 < 4; ++d0) { const bf16x8 a0 = *(const LAS bf16x8*)(kb_ + d0 * 32), a1 = *(const LAS bf16x8*)(kb_ + 32 * KROW + d0 * 32); \
            p0 = __builtin_amdgcn_mfma_f32_32x32x16_bf16(a0, qf[d0], p0, 0, 0, 0); p1 = __builtin_amdgcn_mfma_f32_32x32x16_bf16(a1, qf[d0], p1, 0, 0, 0); } } while (0)
    f32x16 p0, p1;
    DA_LOADK(DA_TILE(0)); DA_LOADV(DA_TILE(0)); DA_STOREK(0); DA_STOREV(0);
    if (nt > 1) { DA_LOADK(DA_TILE(1)); DA_STOREK(1); }
    __syncthreads();
    DA_CINIT(DA_TILE(0)); DA_QK(0);
    if (grp == 1) DA_BAR();
    for (int j = 0; j < nt; ++j) {
        const int t = DA_TILE(j);
        if (j + 2 < nt) DA_LOADK(DA_TILE(j + 2));
        if (j + 1 < nt) DA_LOADV(DA_TILE(j + 1));
        float tm;
        { float ma = __builtin_fmaxf(p0[0], p1[0]), mb = __builtin_fmaxf(p0[1], p1[1]);
#pragma unroll
          for (int r = 2; r < 16; r += 2) { ma = __builtin_fmaxf(__builtin_fmaxf(ma, p0[r]), p1[r]); mb = __builtin_fmaxf(__builtin_fmaxf(mb, p0[r + 1]), p1[r + 1]); }
          tm = __builtin_fmaxf(ma, mb); }
        tm = __builtin_fmaxf(tm, __shfl_xor(tm, 32));
        if (j == 0 || __any(tm > 8.f)) {
            const float dq = (j == 0) ? tm : __builtin_fmaxf(tm, 0.f), al = (j == 0) ? 1.f : __builtin_amdgcn_exp2f(-dq);
            mref += dq;
#pragma unroll
            for (int r = 0; r < 16; ++r) { p0[r] -= dq; p1[r] -= dq; }
            lsum *= al;
#pragma unroll
            for (int i = 0; i < 4; ++i)
#pragma unroll
                for (int r = 0; r < 16; ++r) o[i][r] *= al;
        }
        { float rs0 = 0.f, rs1 = 0.f;
#pragma unroll
        for (int r = 0; r < 16; ++r) { p0[r] = __builtin_amdgcn_exp2f(p0[r]); p1[r] = __builtin_amdgcn_exp2f(p1[r]); rs0 += p0[r]; rs1 += p1[r]; }
        lsum += rs0 + rs1; }
        bf16x8 pf[4]; pf[0] = pack8f(p0, 0); pf[1] = pack8f(p0, 8); pf[2] = pack8f(p1, 0); pf[3] = pack8f(p1, 8);
        if (j + 1 < nt) DA_CINIT(DA_TILE(j + 1));
        DA_BAR();
        { const LAS unsigned char* vb_ = lds + 2 * KT_BYTES + (j & 1) * VT_BYTES + vrd;
          const LAS unsigned char* kb_ = lds + ((j + 1) & 1) * KT_BYTES + krd;
          const bool hasn = (j + 1 < nt);
          bf16x8 fa[4], fb[4];
#define DA_RDV(dst, db) _Pragma("unroll") for (int i = 0; i < 4; ++i) dst[i] = *(const LAS bf16x8*)(vb_ + (db) * 32 * VROW + i * 32)
#define DA_RDK(dst, h2) _Pragma("unroll") for (int i = 0; i < 4; ++i) dst[i] = *(const LAS bf16x8*)(kb_ + (i & 1) * 32 * KROW + ((h2) * 2 + (i >> 1)) * 32)
#define DA_PV(src, db) _Pragma("unroll") for (int i = 0; i < 4; ++i) o[db] = __builtin_amdgcn_mfma_f32_32x32x16_bf16(src[i], pf[i], o[db], 0, 0, 0)
#define DA_SB() __builtin_amdgcn_sched_barrier(0)
          DA_RDV(fa, 0); DA_SB(); DA_RDV(fb, 1); DA_SB();
          DA_PV(fa, 0); DA_SB(); DA_RDV(fa, 2); DA_SB();
          DA_PV(fb, 1); DA_SB(); DA_RDV(fb, 3); DA_SB();
          DA_PV(fa, 2); DA_SB();
          if (hasn) { DA_RDK(fa, 0); } DA_SB();
          DA_PV(fb, 3);
          DA_SB();
          if (hasn) {
              DA_RDK(fb, 1); DA_SB();
              p0 = __builtin_amdgcn_mfma_f32_32x32x16_bf16(fa[0], qf[0], p0, 0, 0, 0); p1 = __builtin_amdgcn_mfma_f32_32x32x16_bf16(fa[1], qf[0], p1, 0, 0, 0);
              p0 = __builtin_amdgcn_mfma_f32_32x32x16_bf16(fa[2], qf[1], p0, 0, 0, 0); p1 = __builtin_amdgcn_mfma_f32_32x32x16_bf16(fa[3], qf[1], p1, 0, 0, 0);
              DA_SB();
              p0 = __builtin_amdgcn_mfma_f32_32x32x16_bf16(fb[0], qf[2], p0, 0, 0, 0); p1 = __builtin_amdgcn_mfma_f32_32x32x16_bf16(fb[1], qf[2], p1, 0, 0, 0);
              p0 = __builtin_amdgcn_mfma_f32_32x32x16_bf16(fb[2], qf[3], p0, 0, 0, 0); p1 = __builtin_amdgcn_mfma_f32_32x32x16_bf16(fb[3], qf[3], p1, 0, 0, 0);
          }
#undef DA_RDV
#undef DA_RDK
#undef DA_PV
#undef DA_SB
        }
        if (j + 2 < nt) DA_STOREK(j & 1);
        if (j + 1 < nt) DA_STOREV((j + 1) & 1);
        DA_BAR();
    }
    if (grp == 0) DA_BAR();
#undef DA_LOADK
#undef DA_LOADV
#undef DA_STOREK
#undef DA_STOREV
#undef DA_QK
#undef DA_CINIT
#undef DA_BAR
#undef DA_TILE
    lsum += __shfl_xor(lsum, 32);
    const float inv = 1.0f / lsum;
    LAS float* ex = (LAS float*)lds + sub * (128 * EXROW);
    if (c == 1) {
#pragma unroll
        for (int db = 0; db < 4; ++db)
#pragma unroll
            for (int r = 0; r < 16; ++r) ex[(32 * db + (r & 3) + 8 * (r >> 2) + 4 * hi) * EXROW + r32] = o[db][r] * inv;
    }
    __syncthreads();
    if (c == 0) {
        float ssq = 0.f;
#pragma unroll
        for (int db = 0; db < 4; ++db)
#pragma unroll
            for (int r = 0; r < 16; ++r) { const float v = o[db][r] * inv - lam * ex[(32 * db + (r & 3) + 8 * (r >> 2) + 4 * hi) * EXROW + r32]; o[db][r] = v; ssq += v * v; }
        ssq += __shfl_xor(ssq, 32);
        const float rstd = __builtin_amdgcn_rsqf(ssq * (1.0f / 128.0f) + 1e-6f) * 0.8f;
        bf16* op = O + ((size_t)b * SEQ + qrow) * DM + h * 128;
#pragma unroll
        for (int db = 0; db < 4; ++db)
#pragma unroll
            for (int rg = 0; rg < 4; ++rg) { const int d = 32 * db + 8 * rg + 4 * hi; const f32x4 g = *(const f32x4*)(gsub + d);
                v2u w; w.x = cvtpk(o[db][4 * rg] * rstd * g[0], o[db][4 * rg + 1] * rstd * g[1]); w.y = cvtpk(o[db][4 * rg + 2] * rstd * g[2], o[db][4 * rg + 3] * rstd * g[3]);
                *(v2u*)(op + d) = w; }
    }
    __syncthreads();
}
}

struct TrDesc { const float* W; int ldw, col0, K, ncols; bf16* WT; int row0, ilv; const float* ks; };
__device__ __forceinline__ void transpose_item(const TrDesc& d, LAS float* scr, int item, int lane) {
    const int nblk = d.ncols / 32, kb = item / nblk, nb = item % nblk, k0 = 64 * kb, n0 = 32 * nb;
    { const float* src = d.W + (size_t)(k0 + (lane >> 3)) * d.ldw + d.col0 + n0 + (lane & 7) * 4; const size_t st8 = (size_t)8 * d.ldw;
      f32x4 w[8];
#pragma unroll
      for (int i = 0; i < 8; ++i) w[i] = __builtin_nontemporal_load((const f32x4*)(src + (size_t)i * st8));
      if (d.ks) {
#pragma unroll
        for (int i = 0; i < 8; ++i) w[i] = w[i] * d.ks[k0 + (lane >> 3) + 8 * i]; }
#pragma unroll
      for (int i = 0; i < 8; ++i) { LAS float* p = scr + ((lane >> 3) + 8 * i) * 33 + (lane & 7) * 4; p[0] = w[i].x; p[1] = w[i].y; p[2] = w[i].z; p[3] = w[i].w; } }
    asm volatile("s_waitcnt lgkmcnt(0)" ::: "memory");
    const int c = lane & 7;
#pragma unroll
    for (int j = 0; j < 4; ++j) { const int n = (lane >> 3) + 8 * j; const LAS float* s = scr + (8 * c) * 33 + n;
        v4u o; o.x = pk2(s[0 * 33], s[1 * 33]); o.y = pk2(s[2 * 33], s[3 * 33]); o.z = pk2(s[4 * 33], s[5 * 33]); o.w = pk2(s[6 * 33], s[7 * 33]);
        const int nn = n0 + n; const int drow = d.ilv < 0 ? d.row0 + nn : 256 * (nn >> 7) + (nn & 127) + d.ilv;
        *(v4u*)(d.WT + (size_t)drow * d.K + k0 + 8 * c) = o; }
    asm volatile("s_waitcnt lgkmcnt(0)" ::: "memory");
}

struct Args { const float* in[22]; float* out; unsigned char* ws; };
__device__ __forceinline__ const float* kin_ptr(int i) { const __attribute__((address_space(4))) char* kp = (const __attribute__((address_space(4))) char*)__builtin_amdgcn_kernarg_segment_ptr();
    asm volatile("" : "+s"(kp)); return *(const float* const __attribute__((address_space(4)))*)(kp + 8 * i); }

__global__ void __launch_bounds__(512, 2) fwd_megakernel(Args a) {
    extern __shared__ __attribute__((aligned(16))) unsigned char lds_raw[];
    LAS unsigned char* lds = (LAS unsigned char*)lds_raw;
    cg::grid_group grid = cg::this_grid();
    const int tid = threadIdx.x, lane = tid & 63, wave = __builtin_amdgcn_readfirstlane(tid >> 6);
    const int G = gridDim.x, bid = blockIdx.x;
    if (tid < 2) ((volatile LAS unsigned*)(lds + LDS_XB_OFF))[tid] = 0u;
    __syncthreads();
    const XcdBarrier xbar = xcd_barrier_post((unsigned*)((unsigned char*)kin_ptr(23) + WS_XBAR), (volatile LAS unsigned*)(lds + LDS_XB_OFF));
#define KIN(i) kin_ptr(i)
#define xin KIN(0)
#define pin KIN(1)
#define g_mix KIN(2)
#define w_in KIN(3)
#define lq1 KIN(4)
#define lk1 KIN(5)
#define lq2 KIN(6)
#define lk2 KIN(7)
#define g_subln KIN(8)
#define w_fo KIN(9)
#define w_ao KIN(10)
#define w_bg KIN(11)
#define b_bg KIN(12)
#define w_o KIN(13)
#define g_ffn KIN(14)
#define w_fg KIN(15)
#define w_fu KIN(16)
#define w_fd KIN(17)
#define g_ple KIN(18)
#define w_pg KIN(19)
#define w_pp KIN(20)
#define g_final KIN(21)
#define out ((float*)KIN(22))
#define ws ((unsigned char*)KIN(23))
#define ss1 ((float*)(ws + WS_CTL))
#define ss2 (ss1 + MTOK)
#define ss3 (ss1 + 2 * MTOK)
#define W1t ((bf16*)(ws + WS_W1T))
#define W2t ((bf16*)(ws + WS_W2T))
#define Wft ((bf16*)(ws + WS_WFT))
#define Wat ((bf16*)(ws + WS_WAT))
#define Wot ((bf16*)(ws + WS_WOT))
#define Wgut ((bf16*)(ws + WS_WGUT))
#define Wdt ((bf16*)(ws + WS_WDT))
#define Wpgt ((bf16*)(ws + WS_WPGT))
#define Wppt ((bf16*)(ws + WS_WPPT))
#define Pb ((bf16*)(ws + WS_PB))
#define XN ((bf16*)(ws + WS_XN))
#define Yb ((bf16*)(ws + WS_ZT))
#define X1b XN
#define Qb ((bf16*)(ws + WS_Q))
#define Ob Qb
#define Kb ((bf16*)(ws + WS_K))
#define MG Kb
#define VT ((bf16*)(ws + WS_VT))
#define PP VT
#define ZT ((bf16*)(ws + WS_ZT))
#define Hb ZT
#define XNp ((bf16*)(ws + WS_DM))
#define Gt ((bf16*)out)
#define T32 ((bf16*)(ws + WS_T32))
    const int gw = bid * 8 + wave, NGW = G * 8, gt = bid * 512 + tid, NGT = G * 512;

    PH_BEGIN(0)
    {
        LAS float* scr = (LAS float*)(lds + wave * 16384);
        constexpr int NI[12] = {512, 512, 1024, 512, 512, 512, 512, 1408, 1408, 1408, 512, 128};
        constexpr int NITEMS = 512 * 7 + 1024 + 1408 * 3 + 128;
        for (int it = gw; it < NITEMS; it += NGW) {
            int r = it, mi = 0;
#pragma unroll
            for (int q = 0; q < 11; ++q) { if (mi == q && r >= NI[q]) { r -= NI[q]; mi = q + 1; } }
            TrDesc d;
            switch (mi) {
                case 0: d = TrDesc{w_in, 4096, 1024, 1024, 1024, W1t, 0, -1, nullptr}; break;
                case 1: d = TrDesc{w_in, 4096, 2048, 1024, 1024, W1t, 1024, -1, nullptr}; break;
                case 2: d = TrDesc{w_bg, 2048, 0, 1024, 2048, W1t, 2048, -1, nullptr}; break;
                case 3: d = TrDesc{w_in, 4096, 3072, 1024, 1024, W2t, 1024, -1, nullptr}; break;
                case 4: d = TrDesc{w_fo, 1024, 0, 1024, 1024, Wft, 0, -1, nullptr}; break;
                case 5: d = TrDesc{w_ao, 1024, 0, 1024, 1024, Wat, 0, -1, nullptr}; break;
                case 6: d = TrDesc{w_o, 1024, 0, 1024, 1024, Wot, 0, -1, nullptr}; break;
                case 7: d = TrDesc{w_fg, 2816, 0, 1024, 2816, Wgut, 0, 0, g_ffn}; break;
                case 8: d = TrDesc{w_fu, 2816, 0, 1024, 2816, Wgut, 0, 128, g_ffn}; break;
                case 9: d = TrDesc{w_fd, 1024, 0, 2816, 1024, Wdt, 0, -1, nullptr}; break;
                case 10: d = TrDesc{w_pg, 1024, 0, 1024, 1024, Wpgt, 0, -1, g_ple}; break;
                default: d = TrDesc{w_pp, 1024, 0, 256, 1024, Wppt, 0, -1, nullptr}; break;
            }
            transpose_item(d, scr, r, lane);
        }
        {
            LAS float* Wl = scr;
            LAS float* T = scr + 1024;
            T[lane] = cospif((float)lane * (1.0f / 64.0f)); T[lane + 64] = cospif((float)(lane + 64) * (1.0f / 64.0f));
            for (int it = gw; it < 1024; it += NGW) {
                const int kb8 = it >> 3, g = it & 7, k0 = kb8 * 8;
                asm volatile("s_waitcnt lgkmcnt(0)" ::: "memory");
#pragma unroll
                for (int kk = 0; kk < 8; ++kk) { Wl[kk * 128 + lane] = w_in[(size_t)(k0 + kk) * 4096 + g * 128 + lane]; Wl[kk * 128 + 64 + lane] = w_in[(size_t)(k0 + kk) * 4096 + g * 128 + 64 + lane]; }
                asm volatile("s_waitcnt lgkmcnt(0)" ::: "memory");
                float ac[2][2][8];
#pragma unroll
                for (int i = 0; i < 2; ++i)
#pragma unroll
                    for (int j = 0; j < 2; ++j)
#pragma unroll
                        for (int k = 0; k < 8; ++k) ac[i][j][k] = 0.f;
                const int m0 = lane, m1 = lane + 64;
                for (int c = 0; c < 128; ++c) {
                    const int i0 = (c * m0) & 127, i1 = (c * m1) & 127;
                    const float c0 = T[i0], s0 = T[(i0 + 96) & 127], c1 = T[i1], s1 = T[(i1 + 96) & 127];
#pragma unroll
                    for (int k = 0; k < 8; ++k) { const float w = Wl[k * 128 + c]; ac[0][0][k] += w * c0; ac[0][1][k] += w * s0; ac[1][0][k] += w * c1; ac[1][1][k] += w * s1; }
                }
                const float sc = 0.08838834764831845f;
#pragma unroll
                for (int i = 0; i < 2; ++i)
#pragma unroll
                    for (int j = 0; j < 2; ++j) { const int mm = (i ? m1 : m0); const bool valid = j == 0 ? (mm <= 64) : (mm >= 1 && mm <= 63);
                        const int n = j == 0 ? g * 65 + mm : 520 + g * 63 + mm - 1;
                        v4u o; o.x = pk2(ac[i][j][0] * sc, ac[i][j][1] * sc); o.y = pk2(ac[i][j][2] * sc, ac[i][j][3] * sc); o.z = pk2(ac[i][j][4] * sc, ac[i][j][5] * sc); o.w = pk2(ac[i][j][6] * sc, ac[i][j][7] * sc);
                        if (valid) *(v4u*)(W2t + (size_t)n * 1024 + k0) = o; }
            }
        }
        for (int m = gw; m < MTOK; m += 4 * NGW) {
            f32x4 v[4][4]; float sq[4]; int mr[4];
#pragma unroll
            for (int q = 0; q < 4; ++q) { const int mq = m + q * NGW; mr[q] = mq < MTOK ? mq : m; const f32x4* xr = (const f32x4*)(xin + (size_t)mr[q] * DM) + lane;
#pragma unroll
                for (int j = 0; j < 4; ++j) v[q][j] = __builtin_nontemporal_load(&xr[64 * j]); }
            f32x4 gm[4];
#pragma unroll
            for (int j = 0; j < 4; ++j) gm[j] = ((const f32x4*)g_mix)[lane + 64 * j];
#pragma unroll
            for (int q = 0; q < 4; ++q) { float s_ = 0.f;
#pragma unroll
                for (int j = 0; j < 4; ++j) s_ += (v[q][j].x * v[q][j].x + v[q][j].y * v[q][j].y) + (v[q][j].z * v[q][j].z + v[q][j].w * v[q][j].w);
                sq[q] = s_; }
#pragma unroll
            for (int o_ = 1; o_ < 64; o_ <<= 1) {
#pragma unroll
                for (int q = 0; q < 4; ++q) sq[q] += __shfl_xor(sq[q], o_); }
#pragma unroll
            for (int q = 0; q < 4; ++q) { if (m + q * NGW < MTOK) {
                const float rstd = __builtin_amdgcn_rsqf(sq[q] * (1.0f / 1024.0f) + 1e-6f); const int mm = mr[q], mp = (mm & ~4095) | ((mm & 63) << 6) | ((mm >> 6) & 63);
                unsigned long long* o8 = (unsigned long long*)(XN + (size_t)mm * DM) + lane; unsigned long long* q8 = (unsigned long long*)(XNp + (size_t)mp * DM) + lane;
#pragma unroll
                for (int j = 0; j < 4; ++j) { const f32x4 g = gm[j], x_ = v[q][j];
                    const unsigned long long w1 = (unsigned long long)pk2(x_.x * rstd * g.x, x_.y * rstd * g.y) | ((unsigned long long)pk2(x_.z * rstd * g.z, x_.w * rstd * g.w) << 32);
                    o8[64 * j] = w1; q8[64 * j] = w1; } } }
        }
        { const v4u z = {0u, 0u, 0u, 0u};
          for (int i = gt; i < 8 * 8 * 2 * 64 * 8; i += NGT) { const int ch = i & 7, s2 = (i >> 3) & 63, mm = ((i >> 9) & 1) * 64, g = (i >> 10) & 7, b = i >> 13;
              *(v4u*)(ZT + (((size_t)(b * 640 + g * 80 + mm) * 64 + s2) * 128 + 64 + ch * 8)) = z; } }
        for (int i = gt; i < MTOK * PLE / 8; i += 4 * NGT) { f32x4 a0[4], a1[4];
#pragma unroll
            for (int q = 0; q < 4; ++q) { const int iq = (i + q * NGT < MTOK * PLE / 8) ? i + q * NGT : i; a0[q] = __builtin_nontemporal_load(&((const f32x4*)pin)[2 * iq]); a1[q] = __builtin_nontemporal_load(&((const f32x4*)pin)[2 * iq + 1]); }
#pragma unroll
            for (int q = 0; q < 4; ++q) { if (i + q * NGT < MTOK * PLE / 8) { v4u o; o.x = pk2(a0[q].x, a0[q].y); o.y = pk2(a0[q].z, a0[q].w); o.z = pk2(a1[q].x, a1[q].y); o.w = pk2(a1[q].z, a1[q].w); ((v4u*)Pb)[i + q * NGT] = o; } } }
        { bf16* F1 = (bf16*)(ws + WS_F1); bf16* F3 = (bf16*)(ws + WS_F3); float* TWp = (float*)(ws + WS_TW);
          for (int i = gt; i < 32768; i += NGT) { const int rt = i >> 7, Kc = i & 127; float v1 = 0.f, v3 = 0.f;
              if (rt < 128) { const int m_ = (rt >> 4) & 3, ri = m_ & 1, k1 = 32 * (rt >> 6) + 16 * (m_ >> 1) + (rt & 15), part = Kc >> 6, s1 = Kc & 63; const float x = (float)((k1 * s1) & 63) * (1.0f / 32.0f);
                  const float cv = cospif(x), sv = sinpif(x); v1 = ri == 0 ? (part == 0 ? cv : -sv) : (part == 0 ? sv : cv); }
              if (rt < 64) { const int ri = Kc >> 6, s2 = Kc & 63; const float x = (float)((rt * s2) & 63) * (1.0f / 32.0f); v3 = (ri == 0 ? cospif(x) : -sinpif(x)) * (1.0f / 64.0f); }
              F1[i] = (bf16)f2bf(v1); F3[i] = (bf16)f2bf(v3); }
          for (int i = gt; i < 4096; i += NGT) { const int k1 = i >> 6, s2 = i & 63; const float x = (float)(k1 * s2) * (1.0f / 2048.0f); TWp[2 * i] = cospif(x); TWp[2 * i + 1] = sinpif(x); } }
    }
    PH_END(0)
    if (G == 0x7fffffff) grid.sync();
    xcd_barrier(xbar);

    PH_BEGIN(1)
#ifndef NO_G1A
    { pg8::Gemm g{XN, W1t, MTOK, 4096, 1024}; pg8::StaticOrder S; S.init(MTOK, 4096, G, bid);
      pg8::EpiQKG E{Qb, Kb, Gt, b_bg, 0.125f * LOG2E};
      pg8::gemm_phase<pg8::EpiQKG, pg8::StaticOrder, true, true>(lds, g, S, E); }
#endif
#ifndef NO_G1B
    { pg8::Gemm g{W2t, XNp, 1024, MTOK, 1024}; pg8::StaticOrder S; S.init(1024, MTOK, G, bid);
      pg8::EpiZ4 E{ZT};
      pg8::gemm_phase<pg8::EpiZ4, pg8::StaticOrder, true, true>(lds, g, S, E); }
    { pg8::Gemm g{W2t + (size_t)1024 * 1024, XN, 1024, MTOK, 1024}; pg8::StaticOrder S; S.init(1024, MTOK, G, bid);
      pg8::EpiVT E{VT};
      pg8::gemm_phase<pg8::EpiVT, pg8::StaticOrder, true, true>(lds, g, S, E); }
#endif
    PH_END(1)
    xcd_barrier(xbar);
#if PROBE_PHASE == 99
    PH_BEGIN(99)
    grid.sync();
    PH_END(99)
#endif

    PH_BEGIN(20)
#ifndef NO_G2
    { int k128 = 128; asm volatile("" : "+s"(k128));
      { pg8::Gemm g{(const bf16*)(ws + WS_F1), ZT, 256, 327680, k128}; pg8::StaticOrder S; S.init(256, 327680, G, bid);
        pg8::EpiG E{(const float*)(ws + WS_TW), (bf16*)(ws + WS_XN), (bf16*)(ws + WS_DM)};
        pg8::gemm_phase<pg8::EpiG, pg8::StaticOrder, true, true>(lds, g, S, E); }
      xcd_barrier(xbar);
      { pg8::Gemm g{(const bf16*)(ws + WS_F3), (const bf16*)(ws + WS_XN), 256, 163840, k128}; pg8::StaticOrder S; S.init(256, 163840, G, bid);
        pg8::EpiY3 E{Yb, 0};
        pg8::gemm_phase<pg8::EpiY3, pg8::StaticOrder, true, true>(lds, g, S, E); }
      { pg8::Gemm g{(const bf16*)(ws + WS_F3), (const bf16*)(ws + WS_DM), 256, 163840, k128}; pg8::StaticOrder S; S.init(256, 163840, G, (bid + (G >> 1)) % G);
        pg8::EpiY3 E{Yb, 4};
        pg8::gemm_phase<pg8::EpiY3, pg8::StaticOrder, true, true>(lds, g, S, E); } }
#endif
    PH_END(20)
    PH_BEGIN(21)
    {
        const float d1 = wave_sum(lq1[lane] * lk1[lane]), d2 = wave_sum(lq2[lane] * lk2[lane]);
        const float lam = __expf(d1) - __expf(d2) + 0.2f;
        for (int u = bid; u < 2048; u += G) { const int xcd = u & 7, w = u >> 3, bh = xcd * 8 + (w >> 5), qb = ((w >> 5) & 1) ? ((w + 16) & 31) : (w & 31);
#ifndef NO_ATT
            da::attn_unit(lds, bh >> 3, bh & 7, qb, Qb, Kb, VT, Ob, lam, g_subln, (const float*)(ws + WS_QN2), (const float*)(ws + WS_KN2));
#endif
        }
    }
    PH_END(21)
    xcd_barrier(xbar);

    PH_BEGIN(3)
#ifndef NO_G3A
    { pg8::Gemm g{Yb, Wft, MTOK, 1024, 1024}; pg8::StaticOrder S; S.init(MTOK, 1024, G, bid);
      pg8::EpiGateF E{Gt, T32};
      pg8::gemm_phase<pg8::EpiGateF, pg8::StaticOrder, true, true>(lds, g, S, E); }
#endif
#ifndef NO_G3B
    { pg8::Gemm g{Ob, Wat, MTOK, 1024, 1024}; pg8::StaticOrder S; S.init(MTOK, 1024, G, bid);
      pg8::EpiGateA E{Gt, T32, MG};
      pg8::gemm_phase<pg8::EpiGateA, pg8::StaticOrder, true, true>(lds, g, S, E); }
#endif
    PH_END(3)
    xcd_barrier(xbar);

    PH_BEGIN(4)
#ifndef NO_G4A
    { pg8::Gemm g{MG, Wot, MTOK, 1024, 1024}; pg8::StaticOrder S; S.init(MTOK, 1024, G, bid);
      pg8::EpiResid<false> E{xin, X1b, ss1};
      pg8::gemm_phase<pg8::EpiResid<false>, pg8::StaticOrder, true, true>(lds, g, S, E); }
#endif
#ifndef NO_G4B
    { int kpp = 256; asm volatile("" : "+s"(kpp)); pg8::Gemm g{Pb, Wppt, MTOK, 1024, kpp}; pg8::StaticOrder S; S.init(MTOK, 1024, G, bid);
      pg8::EpiPlain E{PP, 1024};
      pg8::gemm_phase<pg8::EpiPlain, pg8::StaticOrder, true, true>(lds, g, S, E); }
#endif
    PH_END(4)
    xcd_barrier(xbar);

    PH_BEGIN(5)
#ifndef NO_G5
    { pg8::Gemm g{X1b, Wgut, MTOK, 2 * DFF, 1024}; pg8::StaticOrder S; S.init(MTOK, 2 * DFF, G, bid);
      pg8::EpiSwiGLU E{ss1, Hb};
      pg8::gemm_phase<pg8::EpiSwiGLU, pg8::StaticOrder, true, true>(lds, g, S, E); }
#endif
    PH_END(5)
    xcd_barrier(xbar);

    PH_BEGIN(6)
#ifndef NO_G6
    { pg8::Gemm g{Hb, Wdt, MTOK, 1024, DFF}; pg8::StaticOrder S; S.init(MTOK, 1024, G, bid);
      pg8::EpiResid<true> E{X1b, X1b, ss2};
      pg8::gemm_phase<pg8::EpiResid<true>, pg8::StaticOrder, true, true>(lds, g, S, E); }
#endif
    PH_END(6)
    xcd_barrier(xbar);

    PH_BEGIN(7)
#ifndef NO_G7
    { pg8::Gemm g{X1b, Wpgt, MTOK, 1024, 1024}; pg8::StaticOrder S; S.init(MTOK, 1024, G, bid);
      pg8::EpiPle E{ss2, PP, X1b, Qb, ss3};
      pg8::gemm_phase<pg8::EpiPle, pg8::StaticOrder, true, true>(lds, g, S, E); }
#endif
    PH_END(7)
    xcd_barrier(xbar);

    for (int m = gw; m < MTOK; m += NGW) {
        f32x4* xr = (f32x4*)(out + (size_t)m * DM) + lane; const v2u* xb = (const v2u*)(Qb + (size_t)m * DM) + lane;
        const float rstd = __builtin_amdgcn_rsqf(ss3[m] * (1.0f / 1024.0f) + 1e-6f);
#pragma unroll
        for (int j = 0; j < 4; ++j) { const f32x4 g = ((const f32x4*)g_final)[lane + 64 * j]; const v2u w = __builtin_nontemporal_load(&xb[64 * j]);
            const f32x4 v = {__uint_as_float(w.x << 16), __uint_as_float(w.x & 0xffff0000u), __uint_as_float(w.y << 16), __uint_as_float(w.y & 0xffff0000u)};
            __builtin_nontemporal_store(v * rstd * g, &xr[64 * j]); }
    }
}

#undef xin
#undef pin
#undef g_mix
#undef w_in
#undef lq1
#undef lk1
#undef lq2
#undef lk2
#undef g_subln
#undef w_fo
#undef w_ao
#undef w_bg
#undef b_bg
#undef w_o
#undef g_ffn
#undef w_fg
#undef w_fu
#undef w_fd
#undef g_ple
#undef w_pg
#undef w_pp
#undef g_final
#undef out
#undef ws
#undef ss1
#undef ss2
#undef ss3
#undef W1t
#undef W2t
#undef Wft
#undef Wat
#undef Wot
#undef Wgut
#undef Wdt
#undef Wpgt
#undef Wppt
#undef Pb
#undef XN
#undef Yb
#undef X1b
#undef Qb
#undef Ob
#undef Kb
#undef MG
#undef VT
#undef PP
#undef ZT
#undef Hb
#undef XNp
#undef Gt
#undef T32
#undef KIN
extern "C" void kernel_launch(void* const* d_in, const int* in_sizes, int n_in, void* d_out, int out_size, void* d_ws, size_t ws_size, hipStream_t stream) {
    static int grid = 0;
    if (grid == 0) {
        if (n_in != 22 || in_sizes[0] != MTOK * DM || out_size != MTOK * DM || ws_size < WS_END) { fprintf(stderr, "kernel_launch: unexpected shapes / workspace (n_in %d, ws %zu)\n", n_in, ws_size); grid = -1; return; }
        int dev = 0, cus = 0, per_cu = 0;
        if (hipGetDevice(&dev) != hipSuccess || hipDeviceGetAttribute(&cus, hipDeviceAttributeMultiprocessorCount, dev) != hipSuccess) { grid = -1; return; }
        if (hipFuncSetAttribute((const void*)fwd_megakernel, hipFuncAttributeMaxDynamicSharedMemorySize, LDS_BYTES) != hipSuccess) { fprintf(stderr, "kernel_launch: hipFuncSetAttribute failed\n"); grid = -1; return; }
        if (hipOccupancyMaxActiveBlocksPerMultiprocessor(&per_cu, (const void*)fwd_megakernel, 512, LDS_BYTES) != hipSuccess || per_cu < 1) { fprintf(stderr, "kernel_launch: occupancy query failed (%d)\n", per_cu); (void)hipGetLastError(); per_cu = 1; }
        grid = cus * per_cu;
    }
    if (grid < 0) return;
    (void)hipMemsetAsync((char*)d_ws + WS_CTL, 0, CTL_ZERO_BYTES, stream);
    (void)hipMemsetAsync((char*)d_ws + WS_QN2, 0, NRM_ZERO_BYTES, stream);
    Args a{};
    for (int i = 0; i < 22; ++i) a.in[i] = (const float*)d_in[i];
    a.out = (float*)d_out; a.ws = (unsigned char*)d_ws;
    void* args[] = {&a};
    hipError_t e = hipLaunchCooperativeKernel((const void*)fwd_megakernel, dim3(grid), dim3(512), args, LDS_BYTES, stream);
    if (e != hipSuccess) fprintf(stderr, "cooperative launch failed: %s (grid %d)\n", hipGetErrorString(e), grid);
}
```

```cpp
#include <hip/hip_runtime.h>
#include <hip/hip_cooperative_groups.h>
#include <cstdio>
#include <cstdint>
namespace cg = cooperative_groups;
#ifndef PROBE_PHASE
#define PROBE_PHASE -1
#endif
#define PROBE_MULT 4
#define PH_BEGIN(k) unsigned long long t_ph0_##k = 0; if (PROBE_PHASE == (k)) t_ph0_##k = __builtin_amdgcn_s_memrealtime();
#define PH_END(k) if (PROBE_PHASE == (k)) { const unsigned long long t1_ = __builtin_amdgcn_s_memrealtime(), dt_ = t1_ - t_ph0_##k; while (__builtin_amdgcn_s_memrealtime() < t1_ + PROBE_MULT * dt_) __builtin_amdgcn_s_sleep(64); }
namespace pg8 {
#define PG8_LAS __attribute__((address_space(3)))
typedef unsigned short bf16_t;
typedef short bf16x8 __attribute__((ext_vector_type(8)));
typedef float f32x4 __attribute__((ext_vector_type(4)));
typedef unsigned u32x4 __attribute__((ext_vector_type(4)));
constexpr int BM = 256, BK = 64, HALF = 128, HTB = HALF * BK * 2  , STAGE_BYTES = 8 * HTB, NXCD = 8, WGM = 8;

__host__ __device__ __forceinline__ int lds_byte(int r, int c) { const int st = (r >> 4) * 2 + (c >> 5), rr = r & 15, cc = c & 31, ob = rr * 64 + cc * 2; return st * 1024 + (ob ^ (((ob >> 9) & 1) << 5)); }
__host__ __device__ __forceinline__ void stage_rc(int b, int& R, int& C) { const int st = b / 1024, sb = b % 1024, swz = sb ^ (((sb >> 9) & 1) << 5); R = (st >> 1) * 16 + swz / 64; C = (st & 1) * 32 + (swz % 64) / 2; }
__host__ __device__ __forceinline__ int perm32(int rho) { const int n = rho >> 4, i = rho & 15; return 8 * (i >> 2) + 4 * n + (i & 3); }

struct Unit { int pm, pn; };
struct Gemm { const bf16_t* A; const bf16_t* Bt; int M, N, K; };

struct StaticOrder {
    int nM, nN, nwg, G, c;
    __host__ __device__ void init(int M, int N, int G_, int c_) { nM = M / BM; nN = N / BM; nwg = nM * nN; G = G_; c = c_; }
    __host__ __device__ bool next(int i, Unit& u) const {
        const long L = (long)i * G + c; if (L >= nwg) return false;
        int wgid = (int)L; { const int q = nwg / NXCD, r = nwg % NXCD, xcd = wgid % NXCD, off = wgid / NXCD; wgid = (xcd < r ? xcd * (q + 1) : r * (q + 1) + (xcd - r) * q) + off; }
        const int nig = WGM * nN, gid = wgid / nig, fm = gid * WGM, gsz = (nM - fm) < WGM ? (nM - fm) : WGM;
        u.pm = fm + ((wgid % nig) % gsz); u.pn = (wgid % nig) / gsz; return true;
    }
    __device__ __forceinline__ void a_ready(const Unit&) const {}
    __device__ __forceinline__ void done(const Unit&) const {}
};

__device__ __forceinline__ unsigned cvt_pk_bf16(float lo, float hi) { unsigned r; asm volatile("v_cvt_pk_bf16_f32 %0, %1, %2" : "=v"(r) : "v"(lo), "v"(hi)); return r; }
typedef float f32x2 __attribute__((ext_vector_type(2)));

#define EPI_LOOP(...) \
  _Pragma("unroll") for (int ai = 0; ai < 2; ++ai) _Pragma("unroll") for (int m = 0; m < 4; ++m) _Pragma("unroll") for (int bj = 0; bj < 2; ++bj) { \
     const int row = u.pm * BM + ai * HALF + wr * 64 + m * 16 + fr; const int col = u.pn * BM + bj * HALF + wc * 32 + 8 * fq; \
     f32x4 v0 = acc[ai][bj][m][0], v1 = acc[ai][bj][m][1]; __VA_ARGS__ }
__device__ __forceinline__ u32x4 pack8(f32x4 v0, f32x4 v1) { u32x4 w; w.x = cvt_pk_bf16(v0[0], v0[1]); w.y = cvt_pk_bf16(v0[2], v0[3]); w.z = cvt_pk_bf16(v1[0], v1[1]); w.w = cvt_pk_bf16(v1[2], v1[3]); return w; }
__device__ __forceinline__ float bf_lo(unsigned w) { return __uint_as_float(w << 16); }
__device__ __forceinline__ float bf_hi(unsigned w) { return __uint_as_float(w & 0xffff0000u); }
__device__ __forceinline__ void unpack8(u32x4 w, f32x4& a, f32x4& b) { a = (f32x4){bf_lo(w.x), bf_hi(w.x), bf_lo(w.y), bf_hi(w.y)}; b = (f32x4){bf_lo(w.z), bf_hi(w.z), bf_lo(w.w), bf_hi(w.w)}; }
__device__ __forceinline__ float sigm(float x) { return __builtin_amdgcn_rcpf(1.0f + __expf(-x)); }
__device__ __forceinline__ f32x4 sigm4(f32x4 x) { return (f32x4){sigm(x[0]), sigm(x[1]), sigm(x[2]), sigm(x[3])}; }
__device__ __forceinline__ float sum8sq(f32x4 a, f32x4 b) { return (a[0] * a[0] + a[1] * a[1]) + (a[2] * a[2] + a[3] * a[3]) + (b[0] * b[0] + b[1] * b[1]) + (b[2] * b[2] + b[3] * b[3]); }

struct EpiQKG {
    static constexpr bool PERM = true, AFTER_DRAIN = false;
    bf16_t* Q; bf16_t* Kb; bf16_t* G; const float* bias; float qscale;
    __device__ __forceinline__ void operator()(const f32x4 (&acc)[2][2][4][2], const Unit& u, int wr, int wc, int fr, int fq) const {
        if (u.pn < 4) { EPI_LOOP( v0 = v0 * qscale; v1 = v1 * qscale; __builtin_nontemporal_store(pack8(v0, v1), (u32x4*)(Q + (size_t)row * 1024 + col));
                                  float sq = sum8sq(v0, v1); sq += __shfl_xor(sq, 16); sq += __shfl_xor(sq, 32);
                                  int rr = row; asm volatile("" : "+v"(rr)); if (fq == 0) __hip_atomic_fetch_add((float*)((char*)Q - (70ll << 20)) + (size_t)(col >> 6) * 32768 + rr, sq, __ATOMIC_RELAXED, __HIP_MEMORY_SCOPE_AGENT); __builtin_amdgcn_sched_barrier(0); ) }
        else if (u.pn < 8) { EPI_LOOP( __builtin_nontemporal_store(pack8(v0, v1), (u32x4*)(Kb + (size_t)row * 1024 + (col - 1024)));
                                  float sq = sum8sq(v0, v1); sq += __shfl_xor(sq, 16); sq += __shfl_xor(sq, 32);
                                  int rr = row; asm volatile("" : "+v"(rr)); if (fq == 0) __hip_atomic_fetch_add((float*)((char*)Q - (68ll << 20)) + (size_t)((col - 1024) >> 6) * 32768 + rr, sq, __ATOMIC_RELAXED, __HIP_MEMORY_SCOPE_AGENT); __builtin_amdgcn_sched_barrier(0); ) }
        else { EPI_LOOP( const int gc = col - 2048; const f32x4 b0 = *(const f32x4*)(bias + gc), b1 = *(const f32x4*)(bias + gc + 4);
                         __builtin_nontemporal_store(pack8(sigm4(v0 + b0), sigm4(v1 + b1)), (u32x4*)(G + (size_t)row * 2048 + gc)); ) }
    }
};
struct EpiZ4 {
    static constexpr bool PERM = true, AFTER_DRAIN = false;
    bf16_t* Z4;
    __device__ __forceinline__ void operator()(const f32x4 (&acc)[2][2][4][2], const Unit& u, int wr, int wc, int fr, int fq) const {
        EPI_LOOP( int part, c; if (row < 520) { const int g_ = row / 65; part = 0; c = g_ * 80 + (row - g_ * 65); } else { const int r_ = row - 520, g_ = r_ / 63; part = 1; c = g_ * 80 + (r_ - g_ * 63) + 1; }
                  const int b = col >> 12, s2 = (col >> 6) & 63, s1 = col & 63;
                  *(u32x4*)(Z4 + (((size_t)(b * 640 + c) * 64 + s2) * 128 + part * 64 + s1)) = pack8(v0, v1); )
    }
};
struct EpiVT {
    static constexpr bool PERM = true, AFTER_DRAIN = false;
    bf16_t* VT;
    __device__ __forceinline__ void operator()(const f32x4 (&acc)[2][2][4][2], const Unit& u, int wr, int wc, int fr, int fq) const {
        EPI_LOOP( const int b = col >> 12, s = col & 4095; __builtin_nontemporal_store(pack8(v0, v1), (u32x4*)(VT + ((size_t)(b * 1024 + row)) * 4096 + s)); )
    }
};
struct EpiG {
    static constexpr bool PERM = true, AFTER_DRAIN = false;
    const float* TW; bf16_t* Ga; bf16_t* Gb;
    __device__ __forceinline__ void operator()(const f32x4 (&acc)[2][2][4][2], const Unit& u, int wr, int wc, int fr, int fq) const {
#pragma unroll
        for (int a = 0; a < 2; ++a)
#pragma unroll
            for (int bj = 0; bj < 2; ++bj) {
                const int k1 = 32 * wr + 16 * a + fr, n = u.pn * BM + bj * HALF + wc * 32 + 8 * fq, s2 = n & 63, q_ = n >> 6, b = q_ / 640, c = q_ - b * 640;
                const f32x4 re0 = acc[0][bj][2 * a][0], re1 = acc[0][bj][2 * a][1], im0 = acc[0][bj][2 * a + 1][0], im1 = acc[0][bj][2 * a + 1][1];
                const f32x4* tw = (const f32x4*)(TW + (size_t)(k1 * 64 + s2) * 2);
                const f32x4 t0 = tw[0], t1 = tw[1], t2 = tw[2], t3 = tw[3];
                const f32x4 tr0 = {t0[0], t0[2], t1[0], t1[2]}, ti0 = {t0[1], t0[3], t1[1], t1[3]}, tr1 = {t2[0], t2[2], t3[0], t3[2]}, ti1 = {t2[1], t2[3], t3[1], t3[3]};
                bf16_t* base = (b < 4 ? Ga : Gb) + (((size_t)((b & 3) * 64 + k1) * 640 + c) * 128 + s2);
                *(u32x4*)(base) = pack8(re0 * tr0 - im0 * ti0, re1 * tr1 - im1 * ti1);
                *(u32x4*)(base + 64) = pack8(re0 * ti0 + im0 * tr0, re1 * ti1 + im1 * tr1);
            }
    }
};
struct EpiY3 {
    static constexpr bool PERM = true, AFTER_DRAIN = false;
    bf16_t* Y; int b0;
    __device__ __forceinline__ void operator()(const f32x4 (&acc)[2][2][4][2], const Unit& u, int wr, int wc, int fr, int fq) const {
        if (wr == 0) {
#pragma unroll
            for (int m = 0; m < 4; ++m)
#pragma unroll
                for (int bj = 0; bj < 2; ++bj) { const int k2 = 16 * m + fr, n = u.pn * BM + bj * HALF + wc * 32 + 8 * fq, t_ = n / 640, cp = n - t_ * 640, k1 = t_ & 63, bl = t_ >> 6, g = cp / 80, m0 = cp - g * 80;
                    const int k = k1 + 64 * k2, b = b0 + bl;
                    const u32x4 w = pack8(acc[0][bj][m][0], acc[0][bj][m][1]);
                    bf16_t* yrow = Y + ((size_t)(b * 4096 + k)) * 1024 + g * 128;
                    if (m0 < 64) {
                        *(u32x4*)(yrow + m0) = w;
                        bf16_t* ymir = Y + ((size_t)(b * 4096 + ((4096 - k) & 4095))) * 1024 + g * 128 + 128 - m0;
                        const unsigned ww[4] = {w.x, w.y, w.z, w.w};
#pragma unroll
                        for (int e = 0; e < 8; ++e) { const bf16_t v = (bf16_t)((e & 1) ? (ww[e >> 1] >> 16) : (ww[e >> 1] & 0xffffu)); if (e > 0 || m0 > 0) ymir[-e] = v; }
                    } else if (m0 == 64) yrow[64] = (bf16_t)(w.x & 0xffffu);
                }
        }
    }
};
struct EpiPlain {
    static constexpr bool PERM = true, AFTER_DRAIN = false;
    bf16_t* O; int ldc;
    __device__ __forceinline__ void operator()(const f32x4 (&acc)[2][2][4][2], const Unit& u, int wr, int wc, int fr, int fq) const {
        EPI_LOOP( __builtin_nontemporal_store(pack8(v0, v1), (u32x4*)(O + (size_t)row * ldc + col)); )
    }
};
struct EpiGateF {
    static constexpr bool PERM = true, AFTER_DRAIN = false;
    const bf16_t* G; bf16_t* T32;
    __device__ __forceinline__ void operator()(const f32x4 (&acc)[2][2][4][2], const Unit& u, int wr, int wc, int fr, int fq) const {
        EPI_LOOP( f32x4 g0, g1; unpack8(*(const u32x4*)(G + (size_t)row * 2048 + col), g0, g1);
                  *(u32x4*)(T32 + (size_t)row * 1024 + col) = pack8(g0 * v0, g1 * v1); )
    }
};
struct EpiGateA {
    static constexpr bool PERM = true, AFTER_DRAIN = false;
    const bf16_t* G; const bf16_t* T32; bf16_t* MG;
    __device__ __forceinline__ void operator()(const f32x4 (&acc)[2][2][4][2], const Unit& u, int wr, int wc, int fr, int fq) const {
        EPI_LOOP( f32x4 g0, g1; unpack8(*(const u32x4*)(G + (size_t)row * 2048 + 1024 + col), g0, g1);
                  f32x4 t0, t1; unpack8(*(const u32x4*)(T32 + (size_t)row * 1024 + col), t0, t1);
                  *(u32x4*)(MG + (size_t)row * 1024 + col) = pack8(t0 + g0 * v0, t1 + g1 * v1); )
    }
};
template <bool BASE_BF16> struct EpiResid {
    static constexpr bool PERM = true, AFTER_DRAIN = false;
    const void* base; bf16_t* outb; float* ss;
    __device__ __forceinline__ void operator()(const f32x4 (&acc)[2][2][4][2], const Unit& u, int wr, int wc, int fr, int fq) const {
#pragma unroll
        for (int ai = 0; ai < 2; ++ai)
#pragma unroll
            for (int m = 0; m < 4; ++m) { const int row = u.pm * BM + ai * HALF + wr * 64 + m * 16 + fr; float sq = 0.f;
#pragma unroll
                for (int bj = 0; bj < 2; ++bj) { const int col = u.pn * BM + bj * HALF + wc * 32 + 8 * fq; const size_t off = (size_t)row * 1024 + col;
                    f32x4 b0, b1;
                    if (BASE_BF16) unpack8(*(const u32x4*)((const bf16_t*)base + off), b0, b1); else { b0 = *(const f32x4*)((const float*)base + off); b1 = *(const f32x4*)((const float*)base + off + 4); }
                    const f32x4 x0 = b0 + acc[ai][bj][m][0], x1 = b1 + acc[ai][bj][m][1];
                    *(u32x4*)(outb + off) = pack8(x0, x1); sq += sum8sq(x0, x1); }
                sq += __shfl_xor(sq, 16); sq += __shfl_xor(sq, 32);
                if (fq == 0) __hip_atomic_fetch_add(ss + row, sq, __ATOMIC_RELAXED, __HIP_MEMORY_SCOPE_AGENT); }
    }
};
struct EpiSwiGLU {
    static constexpr bool PERM = true, AFTER_DRAIN = false;
    const float* ss; bf16_t* H;
    __device__ __forceinline__ void operator()(const f32x4 (&acc)[2][2][4][2], const Unit& u, int wr, int wc, int fr, int fq) const {
#pragma unroll
        for (int ai = 0; ai < 2; ++ai)
#pragma unroll
            for (int m = 0; m < 4; ++m) { const int row = u.pm * BM + ai * HALF + wr * 64 + m * 16 + fr, f0 = u.pn * HALF + wc * 32 + 8 * fq;
                const float rs = __builtin_amdgcn_rsqf(ss[row] * (1.0f / 1024.0f) + 1e-6f);
                const f32x4 g0 = acc[ai][0][m][0] * rs, g1 = acc[ai][0][m][1] * rs, u0 = acc[ai][1][m][0] * rs, u1 = acc[ai][1][m][1] * rs;
                __builtin_nontemporal_store(pack8(g0 * sigm4(g0) * u0, g1 * sigm4(g1) * u1), (u32x4*)(H + (size_t)row * 2816 + f0)); }
    }
};
struct EpiPle {
    static constexpr bool PERM = true, AFTER_DRAIN = false;
    const float* ss2; const bf16_t* PP; const bf16_t* x; bf16_t* X3b; float* ss3;
    __device__ __forceinline__ void operator()(const f32x4 (&acc)[2][2][4][2], const Unit& u, int wr, int wc, int fr, int fq) const {
#pragma unroll
        for (int ai = 0; ai < 2; ++ai)
#pragma unroll
            for (int m = 0; m < 4; ++m) { const int row = u.pm * BM + ai * HALF + wr * 64 + m * 16 + fr; float sq = 0.f;
                const float rs = __builtin_amdgcn_rsqf(ss2[row] * (1.0f / 1024.0f) + 1e-6f);
#pragma unroll
                for (int bj = 0; bj < 2; ++bj) { const int col = u.pn * BM + bj * HALF + wc * 32 + 8 * fq; const size_t off = (size_t)row * 1024 + col;
                    f32x4 p0, p1; unpack8(*(const u32x4*)(PP + off), p0, p1);
                    f32x4 xb0, xb1; unpack8(*(const u32x4*)(x + off), xb0, xb1);
                    const f32x4 x0 = xb0 + sigm4(acc[ai][bj][m][0] * rs) * p0, x1 = xb1 + sigm4(acc[ai][bj][m][1] * rs) * p1;
                    *(u32x4*)(X3b + off) = pack8(x0, x1); sq += sum8sq(x0, x1); }
                sq += __shfl_xor(sq, 16); sq += __shfl_xor(sq, 32);
                if (fq == 0) __hip_atomic_fetch_add(ss3 + row, sq, __ATOMIC_RELAXED, __HIP_MEMORY_SCOPE_AGENT); }
    }
};
template <class Epi, class Sched, bool ALIGN_EPI = false, bool SP2 = false>
__device__ __forceinline__ void gemm_phase(PG8_LAS unsigned char* lds, const Gemm g, const Sched& S, const Epi& E) {
    int tid_ = threadIdx.x; asm volatile("" : "+v"(tid_));
    const int tid = tid_, wid = __builtin_amdgcn_readfirstlane(tid >> 6), lane = tid & 63, wr = wid >> 2, wc = wid & 3, fr = lane & 15, fq = lane >> 4;
    const int K = g.K, nt = K / BK;
    unsigned voffA[2], voffB[2];
#pragma unroll
    for (int i = 0; i < 2; ++i) { int R, C; stage_rc(tid * 16 + i * 8192, R, C); const int Rb = Epi::PERM ? ((R & ~31) + perm32(R & 31)) : R;
        voffA[i] = (unsigned)(R * K + C) * 2u; voffB[i] = (unsigned)(Rb * K + C) * 2u; }
    const size_t kstep = (size_t)(BK * 2);
    const size_t hstep = (size_t)HALF * K * 2;
    const size_t tstep = 2 * hstep;
    const unsigned ldsw = (unsigned)wid * 1024u;
    const int aoff = lds_byte(wr * 64 + fr, fq * 8), boff = lds_byte(wc * 32 + fr, fq * 8);
#define PG8_SA(b, h) (((b) * 2 + (h)) * HTB)
#define PG8_SB(b, h) ((4 + (b) * 2 + (h)) * HTB)
#define PG8_STAGE(bufoff, gbase, voff) do { _Pragma("unroll") for (int _i = 0; _i < 2; ++_i) \
        __builtin_amdgcn_global_load_lds((const unsigned*)((const char*)(gbase) + (voff)[_i]), (PG8_LAS unsigned*)(lds + (bufoff) + ldsw + _i * 8192), 16, 0, 0); } while (0)
#define PG8_LDA(dst, b, h) do { _Pragma("unroll") for (int m = 0; m < 4; ++m) _Pragma("unroll") for (int k = 0; k < 2; ++k) dst[m][k] = *(const PG8_LAS bf16x8*)(lds + PG8_SA(b, h) + aoff + m * 2048 + k * 1024); } while (0)
#define PG8_LDB(dst, b, h) do { _Pragma("unroll") for (int n = 0; n < 2; ++n) _Pragma("unroll") for (int k = 0; k < 2; ++k) dst[n][k] = *(const PG8_LAS bf16x8*)(lds + PG8_SB(b, h) + boff + n * 2048 + k * 1024); } while (0)
#define PG8_MMA(ai, bj, At, Bt) do { __builtin_amdgcn_s_setprio(1); _Pragma("unroll") for (int m = 0; m < 4; ++m) _Pragma("unroll") for (int n = 0; n < 2; ++n) _Pragma("unroll") for (int k = 0; k < 2; ++k) \
        acc[ai][bj][m][n] = __builtin_amdgcn_mfma_f32_16x16x32_bf16(Bt[n][k], At[m][k], acc[ai][bj][m][n], 0, 0, 0); __builtin_amdgcn_s_setprio(0); } while (0)
#define PG8_WAIT_V(n) asm volatile("s_waitcnt vmcnt(" #n ")" ::: "memory")
#define PG8_WAIT_L(n) asm volatile("s_waitcnt lgkmcnt(" #n ")" ::: "memory")
#define PG8_BAR __builtin_amdgcn_s_barrier()
#define PG8_SCHED __builtin_amdgcn_sched_barrier(0)
    Unit cur, nxt; int ui = 0;
    if (!S.next(0, cur)) return;
    f32x4 acc[2][2][4][2];
#pragma unroll
    for (int a = 0; a < 2; ++a)
#pragma unroll
        for (int b = 0; b < 2; ++b)
#pragma unroll
            for (int m = 0; m < 4; ++m)
#pragma unroll
                for (int n = 0; n < 2; ++n) acc[a][b][m][n] = (f32x4){0.f, 0.f, 0.f, 0.f};
    bf16x8 At[4][2], B0[2][2], B1[2][2];
    const char* cA = (const char*)g.A + (size_t)cur.pm * tstep; const char* cB = (const char*)g.Bt + (size_t)cur.pn * tstep;
    S.a_ready(cur);
    if constexpr (SP2) {
        PG8_STAGE(PG8_SB(0, 0), cB, voffB); PG8_STAGE(PG8_SB(0, 1), cB + hstep, voffB); PG8_STAGE(PG8_SA(0, 0), cA, voffA); PG8_STAGE(PG8_SA(0, 1), cA + hstep, voffA);
        if (wr == 1) PG8_BAR;
        PG8_WAIT_V(2); PG8_BAR;
        PG8_STAGE(PG8_SB(1, 0), cB + kstep, voffB); PG8_STAGE(PG8_SA(1, 0), cA + kstep, voffA); PG8_STAGE(PG8_SB(1, 1), cB + hstep + kstep, voffB);
        PG8_WAIT_V(6); PG8_BAR;
    } else {
        PG8_STAGE(PG8_SB(0, 0), cB, voffB); PG8_STAGE(PG8_SA(0, 0), cA, voffA); PG8_STAGE(PG8_SB(0, 1), cB + hstep, voffB); PG8_STAGE(PG8_SA(0, 1), cA + hstep, voffA);
        if (wr == 1) PG8_BAR;
        PG8_WAIT_V(4); PG8_BAR;
        PG8_STAGE(PG8_SB(1, 0), cB + kstep, voffB); PG8_STAGE(PG8_SA(1, 0), cA + kstep, voffA); PG8_STAGE(PG8_SB(1, 1), cB + hstep + kstep, voffB);
        PG8_WAIT_V(6); PG8_BAR;
    }
    for (;;) {
        const bool has_next = S.next(ui + 1, nxt);
        const char* nA = has_next ? (const char*)g.A + (size_t)nxt.pm * tstep : cA; const char* nB = has_next ? (const char*)g.Bt + (size_t)nxt.pn * tstep : cB;
        for (int t = 0; t < nt; t += 2) {
            const bool last = (t == nt - 2);
            const char* a1 = cA + (size_t)(t + 1) * kstep;
            const char* a2 = last ? nA : cA + (size_t)(t + 2) * kstep; const char* b2 = last ? nB : cB + (size_t)(t + 2) * kstep;
            const char* a3 = a2 + kstep; const char* b3 = b2 + kstep;
            if (last && has_next) S.a_ready(nxt);
            if constexpr (SP2) {
            PG8_LDB(B0, 0, 0); PG8_LDB(B1, 0, 1); PG8_SCHED; PG8_LDA(At, 0, 0); PG8_STAGE(PG8_SA(1, 1), a1 + hstep, voffA);
            PG8_WAIT_V(8); PG8_WAIT_L(0); PG8_BAR; PG8_MMA(0, 0, At, B0); PG8_MMA(0, 1, At, B1); PG8_BAR; PG8_SCHED;
            PG8_LDA(At, 0, 1); PG8_STAGE(PG8_SB(0, 0), b2, voffB); PG8_STAGE(PG8_SB(0, 1), b2 + hstep, voffB); PG8_STAGE(PG8_SA(0, 0), a2, voffA);
            PG8_WAIT_V(8); PG8_WAIT_L(0); PG8_BAR; PG8_MMA(1, 0, At, B0); PG8_MMA(1, 1, At, B1); PG8_BAR; PG8_SCHED;
            PG8_LDB(B0, 1, 0); PG8_LDB(B1, 1, 1); PG8_SCHED; PG8_LDA(At, 1, 0); PG8_STAGE(PG8_SA(0, 1), a2 + hstep, voffA);
            PG8_WAIT_V(8); PG8_WAIT_L(0); PG8_BAR; PG8_MMA(0, 0, At, B0); PG8_MMA(0, 1, At, B1); PG8_BAR; PG8_SCHED;
            PG8_LDA(At, 1, 1); PG8_STAGE(PG8_SB(1, 0), b3, voffB); PG8_STAGE(PG8_SB(1, 1), b3 + hstep, voffB); PG8_STAGE(PG8_SA(1, 0), a3, voffA);
            PG8_WAIT_V(8); PG8_WAIT_L(0); PG8_BAR; PG8_MMA(1, 0, At, B0); PG8_MMA(1, 1, At, B1); PG8_BAR; PG8_SCHED;
            } else {
            PG8_LDB(B0, 0, 0); PG8_SCHED; PG8_LDA(At, 0, 0); PG8_STAGE(PG8_SA(1, 1), a1 + hstep, voffA);
            PG8_WAIT_L(8); PG8_BAR; PG8_WAIT_L(0); PG8_MMA(0, 0, At, B0); PG8_BAR; PG8_SCHED;
            PG8_LDB(B1, 0, 1); PG8_STAGE(PG8_SB(0, 0), b2, voffB);
            PG8_BAR; PG8_WAIT_L(0); PG8_MMA(0, 1, At, B1); PG8_BAR;
            PG8_LDA(At, 0, 1); PG8_STAGE(PG8_SA(0, 0), a2, voffA);
            PG8_BAR; PG8_WAIT_L(0); PG8_MMA(1, 0, At, B0); PG8_BAR; PG8_SCHED;
            PG8_STAGE(PG8_SB(0, 1), b2 + hstep, voffB);
            PG8_WAIT_V(6); PG8_BAR; PG8_MMA(1, 1, At, B1); PG8_BAR;
            PG8_LDB(B0, 1, 0); PG8_SCHED; PG8_LDA(At, 1, 0); PG8_STAGE(PG8_SA(0, 1), a2 + hstep, voffA);
            PG8_WAIT_L(8); PG8_BAR; PG8_WAIT_L(0); PG8_MMA(0, 0, At, B0); PG8_BAR; PG8_SCHED;
            PG8_LDB(B1, 1, 1); PG8_STAGE(PG8_SB(1, 0), b3, voffB);
            PG8_BAR; PG8_WAIT_L(0); PG8_MMA(0, 1, At, B1); PG8_BAR;
            PG8_LDA(At, 1, 1); PG8_STAGE(PG8_SA(1, 0), a3, voffA);
            PG8_BAR; PG8_WAIT_L(0); PG8_MMA(1, 0, At, B0); PG8_BAR; PG8_SCHED;
            PG8_STAGE(PG8_SB(1, 1), b3 + hstep, voffB);
            PG8_WAIT_V(6); PG8_BAR; PG8_MMA(1, 1, At, B1); PG8_BAR;
            }
        }
        if constexpr (ALIGN_EPI) { if (wr == 0) PG8_BAR; }
        if constexpr (!Epi::AFTER_DRAIN) { E(acc, cur, wr, wc, fr, fq); S.done(cur); }
        if (!has_next) break;
#pragma unroll
        for (int a = 0; a < 2; ++a)
#pragma unroll
            for (int b = 0; b < 2; ++b)
#pragma unroll
                for (int m = 0; m < 4; ++m)
#pragma unroll
                    for (int n = 0; n < 2; ++n) acc[a][b][m][n] = (f32x4){0.f, 0.f, 0.f, 0.f};
        cur = nxt; cA = nA; cB = nB; ++ui;
        if constexpr (ALIGN_EPI) { if (wr == 1) PG8_BAR; }
    }
    PG8_WAIT_V(0);
    if constexpr (!ALIGN_EPI) { if (wr == 0) PG8_BAR; }
    PG8_BAR;
    if constexpr (Epi::AFTER_DRAIN) { E.fused(acc, cur, wr, wc, fr, fq, lds, wid, lane); S.done(cur); }
#undef PG8_SA
#undef PG8_SB
#undef PG8_STAGE
#undef PG8_LDA
#undef PG8_LDB
#undef PG8_MMA
#undef PG8_WAIT_V
#undef PG8_WAIT_L
#undef PG8_BAR
#undef PG8_SCHED
}
}

#define LAS __attribute__((address_space(3)))
typedef unsigned short bf16;
typedef unsigned v4u __attribute__((ext_vector_type(4)));
typedef unsigned v2u __attribute__((ext_vector_type(2)));
typedef float f32x4 __attribute__((ext_vector_type(4)));
typedef short bf16x8 __attribute__((ext_vector_type(8)));
typedef float f32x16 __attribute__((ext_vector_type(16)));
constexpr int MTOK = 32768, DM = 1024, SEQ = 4096, NB = 8, NH = 8, DFF = 2816, PLE = 256;
constexpr size_t MiB = 1u << 20;
constexpr size_t WS_CTL = 0, CTL_ZERO_BYTES = 1 * MiB;
constexpr size_t WS_W1T = 1 * MiB, WS_W2T = 9 * MiB, WS_WFT = 15 * MiB, WS_WAT = 17 * MiB, WS_WOT = 19 * MiB, WS_WGUT = 21 * MiB, WS_WDT = 32 * MiB, WS_WPGT = 38 * MiB, WS_WPPT = 40 * MiB, WS_PB = 41 * MiB;
constexpr size_t WS_QN2 = 58 * MiB, WS_KN2 = 60 * MiB, NRM_ZERO_BYTES = 4 * MiB;
constexpr size_t WS_XN = 64 * MiB;
constexpr size_t WS_Q = 128 * MiB; static_assert(WS_Q - WS_QN2 == (70ull << 20) && WS_Q - WS_KN2 == (68ull << 20), "EpiQKG derives the norm arrays from Q");
constexpr size_t WS_K = 192 * MiB;
constexpr size_t WS_VT = 256 * MiB;
constexpr size_t WS_ZT = 320 * MiB;
constexpr size_t WS_DM = 448 * MiB;
constexpr size_t WS_F1 = 57 * MiB, WS_F3 = 57 * MiB + 65536, WS_TW = 57 * MiB + 131072; static_assert(WS_PB + (size_t)MTOK * PLE * 2 <= WS_F1 && WS_TW + 32768 <= WS_QN2, "constants sit between Pb and the norm arrays");
constexpr size_t WS_T32 = 384 * MiB;
constexpr size_t WS_END = 512 * MiB;
constexpr int LDS_BYTES = 131072 + 512;
constexpr int LDS_XB_OFF = 131072 + 256;
constexpr size_t WS_XBAR = 512 * 1024;
constexpr float LOG2E = 1.4426950408889634f;

__device__ __forceinline__ unsigned f2bf(float f) { unsigned u = __builtin_bit_cast(unsigned, f); return (u + 0x7fffu + ((u >> 16) & 1u)) >> 16; }
__device__ __forceinline__ unsigned pk2(float lo, float hi) { return f2bf(lo) | (f2bf(hi) << 16); }
__device__ __forceinline__ float wave_sum(float v) {
#pragma unroll
    for (int o = 1; o < 64; o <<= 1) v += __shfl_xor(v, o);
    return v;
}


typedef __attribute__((address_space(1))) unsigned gu32;
#define XB_TMO      128
#define XB_XCNT(j)  (256  + 64 * (j))
#define XB_XSUB(j)  (1280 + 64 * (j))
#define XB_XGEN(j)  (2304 + 64 * (j))
#define XB_TOP      3328
#define XB_TOPGEN   3392
#define XCD_BAR_WORDS 3456
#define XB_SPIN_CAP (1u << 18)

__device__ __forceinline__ unsigned xb_ld(unsigned* p)              { return __hip_atomic_load(p, __ATOMIC_RELAXED, __HIP_MEMORY_SCOPE_AGENT); }
__device__ __forceinline__ unsigned xb_add(unsigned* p, unsigned v) { return __hip_atomic_fetch_add(p, v, __ATOMIC_RELAXED, __HIP_MEMORY_SCOPE_AGENT); }
__device__ __forceinline__ unsigned xb_xcc_id() { return (unsigned)__builtin_amdgcn_s_getreg((3 << 11) | 20) & 0xFu; }
#define XB_SPIN(cond, bar) do { unsigned _sp = 0; while (cond) { __builtin_amdgcn_s_sleep(1); \
    if ((++_sp & 255u) == 0u) { if (xb_ld(&(bar)[XB_TMO])) break; if (_sp > XB_SPIN_CAP) { atomicAdd(&(bar)[XB_TMO], 1u); break; } } } } while (0)

struct XcdBarrier {
    unsigned* bar; unsigned x;
    volatile LAS unsigned* st;
};

__device__ __forceinline__ XcdBarrier xcd_barrier_post(unsigned* bar, volatile LAS unsigned* st) {
    XcdBarrier b; b.bar = bar; b.x = xb_xcc_id(); b.st = st;
    if (threadIdx.x == 0) (void)xb_add(&bar[XB_XCNT(b.x)], 1u);
    return b;
}
__device__ __forceinline__ void xcd_barrier_complete(unsigned* bar, unsigned x, unsigned& nloc, unsigned& nx) {
    const unsigned G = gridDim.x * gridDim.y * gridDim.z;
    unsigned sum, cnt, mine, sp = 0u;
    for (;;) {
        sum = 0u; cnt = 0u; mine = 0u;
#pragma unroll
        for (unsigned j = 0; j < 16; ++j) { const unsigned c = xb_ld(&bar[XB_XCNT(j)]); sum += c; cnt += (c > 0u) ? 1u : 0u; mine = (j == x) ? c : mine; }
        if (sum == G) break;
        __builtin_amdgcn_s_sleep(1);
        if ((++sp & 255u) == 0u) { if (xb_ld(&bar[XB_TMO])) break; if (sp > XB_SPIN_CAP) { atomicAdd(&bar[XB_TMO], 1u); break; } }
    }
    nloc = mine > 0u ? mine : 1u; nx = cnt > 0u ? cnt : 1u;
}

__device__ __forceinline__ void xcd_barrier(const XcdBarrier& b) {
    asm volatile("s_waitcnt vmcnt(0)" ::: "memory");
    __syncthreads();
    if (threadIdx.x == 0) {
        unsigned* bar = b.bar;
        __builtin_amdgcn_s_waitcnt(0);
        unsigned nloc = b.st[0], nx = b.st[1];
        if (nloc == 0u) { xcd_barrier_complete(bar, b.x, nloc, nx); b.st[0] = nloc; b.st[1] = nx; }
        const unsigned old = xb_add(&bar[XB_XSUB(b.x)], 1u);
        const unsigned gen = old / nloc;
        if (old + 1u == (gen + 1u) * nloc) {
            __builtin_amdgcn_fence(__ATOMIC_RELEASE, "agent");
            asm volatile("s_waitcnt vmcnt(0)" ::: "memory");
            const unsigned og = xb_add(&bar[XB_TOP], 1u);
            const unsigned tg = og / nx;
            if (og + 1u == (tg + 1u) * nx) xb_add(&bar[XB_TOPGEN], 1u);
            else XB_SPIN(xb_ld(&bar[XB_TOPGEN]) == tg, bar);
            __builtin_amdgcn_fence(__ATOMIC_ACQUIRE, "agent");
            xb_add(&bar[XB_XGEN(b.x)], 1u);
            asm volatile("s_waitcnt vmcnt(0)" ::: "memory");
        } else {
            XB_SPIN(xb_ld(&bar[XB_XGEN(b.x)]) == gen, bar);
            __builtin_amdgcn_fence(__ATOMIC_ACQUIRE, "agent");
            asm volatile("s_waitcnt vmcnt(0)" ::: "memory");
        }
    }
    __syncthreads();
}

namespace da {
constexpr int KROW = 272, VROW = 144, KT_BYTES = 64 * KROW, VT_BYTES = 128 * VROW, STG = KT_BYTES + VT_BYTES, EXROW = 33;
static_assert(4 * 128 * EXROW * 4 <= 2 * STG && 2 * STG + 128 <= 131072, "attention LDS");
__device__ __forceinline__ unsigned cvtpk(float lo, float hi) { unsigned r; asm volatile("v_cvt_pk_bf16_f32 %0, %1, %2" : "=v"(r) : "v"(lo), "v"(hi)); return r; }
__device__ __forceinline__ bf16x8 pack8f(const f32x16& p, int b) { v4u w; w.x = cvtpk(p[b], p[b + 1]); w.y = cvtpk(p[b + 2], p[b + 3]); w.z = cvtpk(p[b + 4], p[b + 5]); w.w = cvtpk(p[b + 6], p[b + 7]); return __builtin_bit_cast(bf16x8, w); }

__device__ __forceinline__ void attn_unit(LAS unsigned char* lds, int b, int h, int qb, const bf16* Q, const bf16* __restrict__ K, const bf16* __restrict__ VT, bf16* O, float lam, const float* __restrict__ gsub, const float* __restrict__ QN2, const float* __restrict__ KN2) {
    int tid_ = threadIdx.x; asm volatile("" : "+v"(tid_));
    const int tid = tid_, lane = tid & 63, r32 = lane & 31, hi = lane >> 5; const int wid = __builtin_amdgcn_readfirstlane(tid >> 6), c = wid & 1, sub = wid >> 1;
    const int q0 = qb * 128, qrow = q0 + sub * 32 + r32, t0 = q0 >> 6;
    const float sl2 = __builtin_amdgcn_exp2f(-(float)(h + 1)) * LOG2E;
    bf16x8 qf[4];
    { const bf16* qp = Q + ((size_t)b * SEQ + qrow) * DM + h * 128 + c * 64 + hi * 8;
#pragma unroll
      for (int d0 = 0; d0 < 4; ++d0) qf[d0] = *(const bf16x8*)(qp + d0 * 16); }
    const bf16* Kg = K + (size_t)b * SEQ * DM + h * 128 + (size_t)(tid >> 4) * DM + (tid & 15) * 8;
    const bf16* Vg = VT + ((size_t)(b * NH + h) * 128 + (tid >> 3)) * SEQ + (tid & 7) * 8;
    const int kst = (tid >> 4) * KROW + (tid & 15) * 16, vst = (tid >> 3) * VROW + (tid & 7) * 16;
    const int sw = (r32 & ~12) | ((r32 & 4) << 1) | ((r32 & 8) >> 1);
    const int krd = sw * KROW + c * 128 + hi * 16, vrd = r32 * VROW + hi * 16;
    v4u pre[4];
#define DA_LOADK(t) do { const int kv0_ = (t) * 64; pre[0] = *(const v4u*)(Kg + (size_t)kv0_ * DM); pre[1] = *(const v4u*)(Kg + (size_t)(kv0_ + 32) * DM); } while (0)
#define DA_LOADV(t) do { const int kv0_ = (t) * 64; pre[2] = *(const v4u*)(Vg + kv0_); pre[3] = *(const v4u*)(Vg + (size_t)64 * SEQ + kv0_); } while (0)
#define DA_STOREK(kbuf) do { LAS unsigned char* s_ = lds + (kbuf) * KT_BYTES + kst; *(LAS v4u*)(s_) = pre[0]; *(LAS v4u*)(s_ + 32 * KROW) = pre[1]; } while (0)
#define DA_STOREV(vbuf) do { LAS unsigned char* s_ = lds + 2 * KT_BYTES + (vbuf) * VT_BYTES + vst; *(LAS v4u*)(s_) = pre[2]; *(LAS v4u*)(s_ + 64 * VROW) = pre[3]; } while (0)
    int t_lo, nt;
    {
        float k0m = 0.f, k1m = 0.f, q0m = 0.f, q1m = 0.f;
        { const f32x4* kn0 = (const f32x4*)(KN2 + (size_t)(2 * h) * 32768 + (size_t)b * SEQ) + tid * 2; const f32x4* kn1 = kn0 + 32768 / 4;
          const f32x4 a0 = kn0[0], a1 = kn0[1], b0 = kn1[0], b1 = kn1[1];
          k0m = __builtin_fmaxf(__builtin_fmaxf(__builtin_fmaxf(a0[0], a0[1]), __builtin_fmaxf(a0[2], a0[3])), __builtin_fmaxf(__builtin_fmaxf(a1[0], a1[1]), __builtin_fmaxf(a1[2], a1[3])));
          k1m = __builtin_fmaxf(__builtin_fmaxf(__builtin_fmaxf(b0[0], b0[1]), __builtin_fmaxf(b0[2], b0[3])), __builtin_fmaxf(__builtin_fmaxf(b1[0], b1[1]), __builtin_fmaxf(b1[2], b1[3]))); }
        if (tid < 128) { const float* qn = QN2 + (size_t)(2 * h) * 32768 + (size_t)b * SEQ + q0 + tid; q0m = qn[0]; q1m = qn[32768]; }
        float dmin;
        { const bf16* kp = K + ((size_t)b * SEQ + qrow) * DM + h * 128 + c * 64 + hi * 8; float sp = 0.f;
#pragma unroll
          for (int d0 = 0; d0 < 4; ++d0) { const bf16x8 kd = *(const bf16x8*)(kp + d0 * 16);
#pragma unroll
              for (int j2 = 0; j2 < 8; ++j2) sp += __uint_as_float((unsigned)(unsigned short)qf[d0][j2] << 16) * __uint_as_float((unsigned)(unsigned short)kd[j2] << 16); }
          sp += __shfl_xor(sp, 32); dmin = sp;
#pragma unroll
          for (int o_ = 1; o_ < 32; o_ <<= 1) dmin = __builtin_fminf(dmin, __shfl_xor(dmin, o_)); }
#pragma unroll
        for (int o_ = 1; o_ < 64; o_ <<= 1) { k0m = __builtin_fmaxf(k0m, __shfl_xor(k0m, o_)); k1m = __builtin_fmaxf(k1m, __shfl_xor(k1m, o_)); q0m = __builtin_fmaxf(q0m, __shfl_xor(q0m, o_)); q1m = __builtin_fmaxf(q1m, __shfl_xor(q1m, o_)); }
        LAS float* red = (LAS float*)(lds + 2 * STG);
        if (lane == 0) { red[wid * 4 + 0] = k0m; red[wid * 4 + 1] = k1m; red[wid * 4 + 2] = q0m; red[wid * 4 + 3] = q1m; red[32 + wid] = dmin; }
        __syncthreads();
        k0m = 0.f; k1m = 0.f; q0m = 0.f; q1m = 0.f;
#pragma unroll
        for (int w_ = 0; w_ < 8; ++w_) { k0m = __builtin_fmaxf(k0m, red[w_ * 4 + 0]); k1m = __builtin_fmaxf(k1m, red[w_ * 4 + 1]); q0m = __builtin_fmaxf(q0m, red[w_ * 4 + 2]); q1m = __builtin_fmaxf(q1m, red[w_ * 4 + 3]); }
        const float Bq = 1.02f * __builtin_fmaxf(__builtin_sqrtf(k0m * q0m), __builtin_sqrtf(k1m * q1m));
        float dm = red[32];
#pragma unroll
        for (int w_ = 1; w_ < 8; ++w_) dm = __builtin_fminf(dm, red[32 + w_]);
        dm = __builtin_fmaxf(dm - 0.25f, -Bq);
        const float Rf = (Bq - dm + 40.f) / sl2;
        const int R = Rf < 8192.f ? (int)Rf + 1 : 8192;
        int lo = (q0 - 63 - R); lo = lo <= 0 ? 0 : (lo + 63) >> 6; int hi_t = (q0 + 127 + R) >> 6; hi_t = hi_t > 63 ? 63 : hi_t;
        t_lo = __builtin_amdgcn_readfirstlane(lo); nt = __builtin_amdgcn_readfirstlane(hi_t - lo + 1);
    }
    f32x16 o[4];
#pragma unroll
    for (int i = 0; i < 4; ++i)
#pragma unroll
        for (int r = 0; r < 16; ++r) o[i][r] = 0.f;
    float mref = 0.f;
    float lsum = 0.f;
#define DA_TILE(j_) (t_lo + (((t0 - t_lo) + (j_)) >= nt ? ((t0 - t_lo) + (j_)) - nt : ((t0 - t_lo) + (j_))))
    const float qposf = (float)(qrow - 8 * hi);
    const int grp = wid >> 2;
#define DA_BAR() do { asm volatile("s_waitcnt lgkmcnt(0)" ::: "memory"); __builtin_amdgcn_s_barrier(); asm volatile("" ::: "memory"); } while (0)
#define DA_CINIT(tn) do { const int tn_ = (tn); const float dln_ = qposf - (float)(tn_ * 64); \
        if (tn_ < t0 || tn_ > t0 + 1) { const float ss_ = (tn_ < t0) ? sl2 : -sl2; const float base_ = -ss_ * dln_ - mref; \
            _Pragma("unroll") for (int r = 0; r < 16; ++r) { const float cr = (float)((r & 7) + 16 * (r >> 3)); p0[r] = __builtin_fmaf(cr, ss_, base_); p1[r] = __builtin_fmaf(cr + 32.f, ss_, base_); } } \
        else { _Pragma("unroll") for (int r = 0; r < 16; ++r) { const float cr = (float)((r & 7) + 16 * (r >> 3)); \
            p0[r] = __builtin_fmaf(-sl2, __builtin_fabsf(dln_ - cr), -mref); p1[r] = __builtin_fmaf(-sl2, __builtin_fabsf(dln_ - (cr + 32.f)), -mref); } } } while (0)
#define DA_QK(kbuf) do { const LAS unsigned char* kb_ = lds + (kbuf) * KT_BYTES + krd; \
        _Pragma("unroll") for (int d0 = 0; d0 < 4; ++d0) { const bf16x8 a0 = *(const LAS bf16x8*)(kb_ + d0 * 32), a1 = *(const LAS bf16x8*)(kb_ + 32 * KROW + d0 * 32); \
            p0 = __builtin_amdgcn_mfma_f32_32x32x16_bf16(a0, qf[d0], p0, 0, 0, 0); p1 = __builtin_amdgcn_mfma_f32_32x32x16_bf16(a1, qf[d0], p1, 0, 0, 0); } } while (0)
    f32x16 p0, p1;
    DA_LOADK(DA_TILE(0)); DA_LOADV(DA_TILE(0)); DA_STOREK(0); DA_STOREV(0);
    if (nt > 1) { DA_LOADK(DA_TILE(1)); DA_STOREK(1); }
    __syncthreads();
    DA_CINIT(DA_TILE(0)); DA_QK(0);
    if (grp == 1) DA_BAR();
    for (int j = 0; j < nt; ++j) {
        const int t = DA_TILE(j);
        if (j + 2 < nt) DA_LOADK(DA_TILE(j + 2));
        if (j + 1 < nt) DA_LOADV(DA_TILE(j + 1));
        float tm;
        { float ma = __builtin_fmaxf(p0[0], p1[0]), mb = __builtin_fmaxf(p0[1], p1[1]);
#pragma unroll
          for (int r = 2; r < 16; r += 2) { ma = __builtin_fmaxf(__builtin_fmaxf(ma, p0[r]), p1[r]); mb = __builtin_fmaxf(__builtin_fmaxf(mb, p0[r + 1]), p1[r + 1]); }
          tm = __builtin_fmaxf(ma, mb); }
        tm = __builtin_fmaxf(tm, __shfl_xor(tm, 32));
        if (j == 0 || __any(tm > 8.f)) {
            const float dq = (j == 0) ? tm : __builtin_fmaxf(tm, 0.f), al = (j == 0) ? 1.f : __builtin_amdgcn_exp2f(-dq);
            mref += dq;
#pragma unroll
            for (int r = 0; r < 16; ++r) { p0[r] -= dq; p1[r] -= dq; }
            lsum *= al;
#pragma unroll
            for (int i = 0; i < 4; ++i)
#pragma unroll
                for (int r = 0; r < 16; ++r) o[i][r] *= al;
        }
        { float rs0 = 0.f, rs1 = 0.f;
#pragma unroll
        for (int r = 0; r < 16; ++r) { p0[r] = __builtin_amdgcn_exp2f(p0[r]); p1[r] = __builtin_amdgcn_exp2f(p1[r]); rs0 += p0[r]; rs1 += p1[r]; }
        lsum += rs0 + rs1; }
        bf16x8 pf[4]; pf[0] = pack8f(p0, 0); pf[1] = pack8f(p0, 8); pf[2] = pack8f(p1, 0); pf[3] = pack8f(p1, 8);
        if (j + 1 < nt) DA_CINIT(DA_TILE(j + 1));
        DA_BAR();
        { const LAS unsigned char* vb_ = lds + 2 * KT_BYTES + (j & 1) * VT_BYTES + vrd;
          const LAS unsigned char* kb_ = lds + ((j + 1) & 1) * KT_BYTES + krd;
          const bool hasn = (j + 1 < nt);
          bf16x8 fa[4], fb[4];
#define DA_RDV(dst, db) _Pragma("unroll") for (int i = 0; i < 4; ++i) dst[i] = *(const LAS bf16x8*)(vb_ + (db) * 32 * VROW + i * 32)
#define DA_RDK(dst, h2) _Pragma("unroll") for (int i = 0; i < 4; ++i) dst[i] = *(const LAS bf16x8*)(kb_ + (i & 1) * 32 * KROW + ((h2) * 2 + (i >> 1)) * 32)
#define DA_PV(src, db) _Pragma("unroll") for (int i = 0; i < 4; ++i) o[db] = __builtin_amdgcn_mfma_f32_32x32x16_bf16(src[i], pf[i], o[db], 0, 0, 0)
#define DA_SB() __builtin_amdgcn_sched_barrier(0)
          DA_RDV(fa, 0); DA_SB(); DA_RDV(fb, 1); DA_SB();
          DA_PV(fa, 0); DA_SB(); DA_RDV(fa, 2); DA_SB();
          DA_PV(fb, 1); DA_SB(); DA_RDV(fb, 3); DA_SB();
          DA_PV(fa, 2); DA_SB();
          if (hasn) { DA_RDK(fa, 0); } DA_SB();
          DA_PV(fb, 3);
          DA_SB();
          if (hasn) {
              DA_RDK(fb, 1); DA_SB();
              p0 = __builtin_amdgcn_mfma_f32_32x32x16_bf16(fa[0], qf[0], p0, 0, 0, 0); p1 = __builtin_amdgcn_mfma_f32_32x32x16_bf16(fa[1], qf[0], p1, 0, 0, 0);
              p0 = __builtin_amdgcn_mfma_f32_32x32x16_bf16(fa[2], qf[1], p0, 0, 0, 0); p1 = __builtin_amdgcn_mfma_f32_32x32x16_bf16(fa[3], qf[1], p1, 0, 0, 0);
              DA_SB();
              p0 = __builtin_amdgcn_mfma_f32_32x32x16_bf16(fb[0], qf[2], p0, 0, 0, 0); p1 = __builtin_amdgcn_mfma_f32_32x32x16_bf16(fb[1], qf[2], p1, 0, 0, 0);
              p0 = __builtin_amdgcn_mfma_f32_32x32x16_bf16(fb[2], qf[3], p0, 0, 0, 0); p1 = __builtin_amdgcn_mfma_f32_32x32x16_bf16(fb[3], qf[3], p1, 0, 0, 0);
          }
#undef DA_RDV
#undef DA_RDK
#undef DA_PV
#undef DA_SB
        }
        if (j + 2 < nt) DA_STOREK(j & 1);
        if (j + 1 < nt) DA_STOREV((j + 1) & 1);
        DA_BAR();
    }
    if (grp == 0) DA_BAR();
#undef DA_LOADK
#undef DA_LOADV
#undef DA_STOREK
#undef DA_STOREV
#undef DA_QK
#undef DA_CINIT
#undef DA_BAR
#undef DA_TILE
    lsum += __shfl_xor(lsum, 32);
    const float inv = 1.0f / lsum;
    LAS float* ex = (LAS float*)lds + sub * (128 * EXROW);
    if (c == 1) {
#pragma unroll
        for (int db = 0; db < 4; ++db)
#pragma unroll
            for (int r = 0; r < 16; ++r) ex[(32 * db + (r & 3) + 8 * (r >> 2) + 4 * hi) * EXROW + r32] = o[db][r] * inv;
    }
    __syncthreads();
    if (c == 0) {
        float ssq = 0.f;
#pragma unroll
        for (int db = 0; db < 4; ++db)
#pragma unroll
            for (int r = 0; r < 16; ++r) { const float v = o[db][r] * inv - lam * ex[(32 * db + (r & 3) + 8 * (r >> 2) + 4 * hi) * EXROW + r32]; o[db][r] = v; ssq += v * v; }
        ssq += __shfl_xor(ssq, 32);
        const float rstd = __builtin_amdgcn_rsqf(ssq * (1.0f / 128.0f) + 1e-6f) * 0.8f;
        bf16* op = O + ((size_t)b * SEQ + qrow) * DM + h * 128;
#pragma unroll
        for (int db = 0; db < 4; ++db)
#pragma unroll
            for (int rg = 0; rg < 4; ++rg) { const int d = 32 * db + 8 * rg + 4 * hi; const f32x4 g = *(const f32x4*)(gsub + d);
                v2u w; w.x = cvtpk(o[db][4 * rg] * rstd * g[0], o[db][4 * rg + 1] * rstd * g[1]); w.y = cvtpk(o[db][4 * rg + 2] * rstd * g[2], o[db][4 * rg + 3] * rstd * g[3]);
                *(v2u*)(op + d) = w; }
    }
    __syncthreads();
}
}

struct TrDesc { const float* W; int ldw, col0, K, ncols; bf16* WT; int row0, ilv; const float* ks; };
__device__ __forceinline__ void transpose_item(const TrDesc& d, LAS float* scr, int item, int lane) {
    const int nblk = d.ncols / 32, kb = item / nblk, nb = item % nblk, k0 = 64 * kb, n0 = 32 * nb;
    { const float* src = d.W + (size_t)(k0 + (lane >> 3)) * d.ldw + d.col0 + n0 + (lane & 7) * 4; const size_t st8 = (size_t)8 * d.ldw;
      f32x4 w[8];
#pragma unroll
      for (int i = 0; i < 8; ++i) w[i] = __builtin_nontemporal_load((const f32x4*)(src + (size_t)i * st8));
      if (d.ks) {
#pragma unroll
        for (int i = 0; i < 8; ++i) w[i] = w[i] * d.ks[k0 + (lane >> 3) + 8 * i]; }
#pragma unroll
      for (int i = 0; i < 8; ++i) { LAS float* p = scr + ((lane >> 3) + 8 * i) * 33 + (lane & 7) * 4; p[0] = w[i].x; p[1] = w[i].y; p[2] = w[i].z; p[3] = w[i].w; } }
    asm volatile("s_waitcnt lgkmcnt(0)" ::: "memory");
    const int c = lane & 7;
#pragma unroll
    for (int j = 0; j < 4; ++j) { const int n = (lane >> 3) + 8 * j; const LAS float* s = scr + (8 * c) * 33 + n;
        v4u o; o.x = pk2(s[0 * 33], s[1 * 33]); o.y = pk2(s[2 * 33], s[3 * 33]); o.z = pk2(s[4 * 33], s[5 * 33]); o.w = pk2(s[6 * 33], s[7 * 33]);
        const int nn = n0 + n; const int drow = d.ilv < 0 ? d.row0 + nn : 256 * (nn >> 7) + (nn & 127) + d.ilv;
        *(v4u*)(d.WT + (size_t)drow * d.K + k0 + 8 * c) = o; }
    asm volatile("s_waitcnt lgkmcnt(0)" ::: "memory");
}

struct Args { const float* in[22]; float* out; unsigned char* ws; };
__device__ __forceinline__ const float* kin_ptr(int i) { const __attribute__((address_space(4))) char* kp = (const __attribute__((address_space(4))) char*)__builtin_amdgcn_kernarg_segment_ptr();
    asm volatile("" : "+s"(kp)); return *(const float* const __attribute__((address_space(4)))*)(kp + 8 * i); }

__global__ void __launch_bounds__(512, 2) fwd_megakernel(Args a) {
    extern __shared__ __attribute__((aligned(16))) unsigned char lds_raw[];
    LAS unsigned char* lds = (LAS unsigned char*)lds_raw;
    cg::grid_group grid = cg::this_grid();
    const int tid = threadIdx.x, lane = tid & 63, wave = __builtin_amdgcn_readfirstlane(tid >> 6);
    const int G = gridDim.x, bid = blockIdx.x;
    if (tid < 2) ((volatile LAS unsigned*)(lds + LDS_XB_OFF))[tid] = 0u;
    __syncthreads();
    const XcdBarrier xbar = xcd_barrier_post((unsigned*)((unsigned char*)kin_ptr(23) + WS_XBAR), (volatile LAS unsigned*)(lds + LDS_XB_OFF));
#define KIN(i) kin_ptr(i)
#define xin KIN(0)
#define pin KIN(1)
#define g_mix KIN(2)
#define w_in KIN(3)
#define lq1 KIN(4)
#define lk1 KIN(5)
#define lq2 KIN(6)
#define lk2 KIN(7)
#define g_subln KIN(8)
#define w_fo KIN(9)
#define w_ao KIN(10)
#define w_bg KIN(11)
#define b_bg KIN(12)
#define w_o KIN(13)
#define g_ffn KIN(14)
#define w_fg KIN(15)
#define w_fu KIN(16)
#define w_fd KIN(17)
#define g_ple KIN(18)
#define w_pg KIN(19)
#define w_pp KIN(20)
#define g_final KIN(21)
#define out ((float*)KIN(22))
#define ws ((unsigned char*)KIN(23))
#define ss1 ((float*)(ws + WS_CTL))
#define ss2 (ss1 + MTOK)
#define ss3 (ss1 + 2 * MTOK)
#define W1t ((bf16*)(ws + WS_W1T))
#define W2t ((bf16*)(ws + WS_W2T))
#define Wft ((bf16*)(ws + WS_WFT))
#define Wat ((bf16*)(ws + WS_WAT))
#define Wot ((bf16*)(ws + WS_WOT))
#define Wgut ((bf16*)(ws + WS_WGUT))
#define Wdt ((bf16*)(ws + WS_WDT))
#define Wpgt ((bf16*)(ws + WS_WPGT))
#define Wppt ((bf16*)(ws + WS_WPPT))
#define Pb ((bf16*)(ws + WS_PB))
#define XN ((bf16*)(ws + WS_XN))
#define Yb ((bf16*)(ws + WS_ZT))
#define X1b XN
#define Qb ((bf16*)(ws + WS_Q))
#define Ob Qb
#define Kb ((bf16*)(ws + WS_K))
#define MG Kb
#define VT ((bf16*)(ws + WS_VT))
#define PP VT
#define ZT ((bf16*)(ws + WS_ZT))
#define Hb ZT
#define XNp ((bf16*)(ws + WS_DM))
#define Gt ((bf16*)out)
#define T32 ((bf16*)(ws + WS_T32))
    const int gw = bid * 8 + wave, NGW = G * 8, gt = bid * 512 + tid, NGT = G * 512;

    PH_BEGIN(0)
    {
        LAS float* scr = (LAS float*)(lds + wave * 16384);
        constexpr int NI[12] = {512, 512, 1024, 512, 512, 512, 512, 1408, 1408, 1408, 512, 128};
        constexpr int NITEMS = 512 * 7 + 1024 + 1408 * 3 + 128;
        for (int it = gw; it < NITEMS; it += NGW) {
            int r = it, mi = 0;
#pragma unroll
            for (int q = 0; q < 11; ++q) { if (mi == q && r >= NI[q]) { r -= NI[q]; mi = q + 1; } }
            TrDesc d;
            switch (mi) {
                case 0: d = TrDesc{w_in, 4096, 1024, 1024, 1024, W1t, 0, -1, nullptr}; break;
                case 1: d = TrDesc{w_in, 4096, 2048, 1024, 1024, W1t, 1024, -1, nullptr}; break;
                case 2: d = TrDesc{w_bg, 2048, 0, 1024, 2048, W1t, 2048, -1, nullptr}; break;
                case 3: d = TrDesc{w_in, 4096, 3072, 1024, 1024, W2t, 1024, -1, nullptr}; break;
                case 4: d = TrDesc{w_fo, 1024, 0, 1024, 1024, Wft, 0, -1, nullptr}; break;
                case 5: d = TrDesc{w_ao, 1024, 0, 1024, 1024, Wat, 0, -1, nullptr}; break;
                case 6: d = TrDesc{w_o, 1024, 0, 1024, 1024, Wot, 0, -1, nullptr}; break;
                case 7: d = TrDesc{w_fg, 2816, 0, 1024, 2816, Wgut, 0, 0, g_ffn}; break;
                case 8: d = TrDesc{w_fu, 2816, 0, 1024, 2816, Wgut, 0, 128, g_ffn}; break;
                case 9: d = TrDesc{w_fd, 1024, 0, 2816, 1024, Wdt, 0, -1, nullptr}; break;
                case 10: d = TrDesc{w_pg, 1024, 0, 1024, 1024, Wpgt, 0, -1, g_ple}; break;
                default: d = TrDesc{w_pp, 1024, 0, 256, 1024, Wppt, 0, -1, nullptr}; break;
            }
            transpose_item(d, scr, r, lane);
        }
        {
            LAS float* Wl = scr;
            LAS float* T = scr + 1024;
            T[lane] = cospif((float)lane * (1.0f / 64.0f)); T[lane + 64] = cospif((float)(lane + 64) * (1.0f / 64.0f));
            for (int it = gw; it < 1024; it += NGW) {
                const int kb8 = it >> 3, g = it & 7, k0 = kb8 * 8;
                asm volatile("s_waitcnt lgkmcnt(0)" ::: "memory");
#pragma unroll
                for (int kk = 0; kk < 8; ++kk) { Wl[kk * 128 + lane] = w_in[(size_t)(k0 + kk) * 4096 + g * 128 + lane]; Wl[kk * 128 + 64 + lane] = w_in[(size_t)(k0 + kk) * 4096 + g * 128 + 64 + lane]; }
                asm volatile("s_waitcnt lgkmcnt(0)" ::: "memory");
                float ac[2][2][8];
#pragma unroll
                for (int i = 0; i < 2; ++i)
#pragma unroll
                    for (int j = 0; j < 2; ++j)
#pragma unroll
                        for (int k = 0; k < 8; ++k) ac[i][j][k] = 0.f;
                const int m0 = lane, m1 = lane + 64;
                for (int c = 0; c < 128; ++c) {
                    const int i0 = (c * m0) & 127, i1 = (c * m1) & 127;
                    const float c0 = T[i0], s0 = T[(i0 + 96) & 127], c1 = T[i1], s1 = T[(i1 + 96) & 127];
#pragma unroll
                    for (int k = 0; k < 8; ++k) { const float w = Wl[k * 128 + c]; ac[0][0][k] += w * c0; ac[0][1][k] += w * s0; ac[1][0][k] += w * c1; ac[1][1][k] += w * s1; }
                }
                const float sc = 0.08838834764831845f;
#pragma unroll
                for (int i = 0; i < 2; ++i)
#pragma unroll
                    for (int j = 0; j < 2; ++j) { const int mm = (i ? m1 : m0); const bool valid = j == 0 ? (mm <= 64) : (mm >= 1 && mm <= 63);
                        const int n = j == 0 ? g * 65 + mm : 520 + g * 63 + mm - 1;
                        v4u o; o.x = pk2(ac[i][j][0] * sc, ac[i][j][1] * sc); o.y = pk2(ac[i][j][2] * sc, ac[i][j][3] * sc); o.z = pk2(ac[i][j][4] * sc, ac[i][j][5] * sc); o.w = pk2(ac[i][j][6] * sc, ac[i][j][7] * sc);
                        if (valid) *(v4u*)(W2t + (size_t)n * 1024 + k0) = o; }
            }
        }
        for (int m = gw; m < MTOK; m += 4 * NGW) {
            f32x4 v[4][4]; float sq[4]; int mr[4];
#pragma unroll
            for (int q = 0; q < 4; ++q) { const int mq = m + q * NGW; mr[q] = mq < MTOK ? mq : m; const f32x4* xr = (const f32x4*)(xin + (size_t)mr[q] * DM) + lane;
#pragma unroll
                for (int j = 0; j < 4; ++j) v[q][j] = __builtin_nontemporal_load(&xr[64 * j]); }
            f32x4 gm[4];
#pragma unroll
            for (int j = 0; j < 4; ++j) gm[j] = ((const f32x4*)g_mix)[lane + 64 * j];
#pragma unroll
            for (int q = 0; q < 4; ++q) { float s_ = 0.f;
#pragma unroll
                for (int j = 0; j < 4; ++j) s_ += (v[q][j].x * v[q][j].x + v[q][j].y * v[q][j].y) + (v[q][j].z * v[q][j].z + v[q][j].w * v[q][j].w);
                sq[q] = s_; }
#pragma unroll
            for (int o_ = 1; o_ < 64; o_ <<= 1) {
#pragma unroll
                for (int q = 0; q < 4; ++q) sq[q] += __shfl_xor(sq[q], o_); }
#pragma unroll
            for (int q = 0; q < 4; ++q) { if (m + q * NGW < MTOK) {
                const float rstd = __builtin_amdgcn_rsqf(sq[q] * (1.0f / 1024.0f) + 1e-6f); const int mm = mr[q], mp = (mm & ~4095) | ((mm & 63) << 6) | ((mm >> 6) & 63);
                unsigned long long* o8 = (unsigned long long*)(XN + (size_t)mm * DM) + lane; unsigned long long* q8 = (unsigned long long*)(XNp + (size_t)mp * DM) + lane;
#pragma unroll
                for (int j = 0; j < 4; ++j) { const f32x4 g = gm[j], x_ = v[q][j];
                    const unsigned long long w1 = (unsigned long long)pk2(x_.x * rstd * g.x, x_.y * rstd * g.y) | ((unsigned long long)pk2(x_.z * rstd * g.z, x_.w * rstd * g.w) << 32);
                    o8[64 * j] = w1; q8[64 * j] = w1; } } }
        }
        { const v4u z = {0u, 0u, 0u, 0u};
          for (int i = gt; i < 8 * 8 * 2 * 64 * 8; i += NGT) { const int ch = i & 7, s2 = (i >> 3) & 63, mm = ((i >> 9) & 1) * 64, g = (i >> 10) & 7, b = i >> 13;
              *(v4u*)(ZT + (((size_t)(b * 640 + g * 80 + mm) * 64 + s2) * 128 + 64 + ch * 8)) = z; } }
        for (int i = gt; i < MTOK * PLE / 8; i += 4 * NGT) { f32x4 a0[4], a1[4];
#pragma unroll
            for (int q = 0; q < 4; ++q) { const int iq = (i + q * NGT < MTOK * PLE / 8) ? i + q * NGT : i; a0[q] = __builtin_nontemporal_load(&((const f32x4*)pin)[2 * iq]); a1[q] = __builtin_nontemporal_load(&((const f32x4*)pin)[2 * iq + 1]); }
#pragma unroll
            for (int q = 0; q < 4; ++q) { if (i + q * NGT < MTOK * PLE / 8) { v4u o; o.x = pk2(a0[q].x, a0[q].y); o.y = pk2(a0[q].z, a0[q].w); o.z = pk2(a1[q].x, a1[q].y); o.w = pk2(a1[q].z, a1[q].w); ((v4u*)Pb)[i + q * NGT] = o; } } }
        { bf16* F1 = (bf16*)(ws + WS_F1); bf16* F3 = (bf16*)(ws + WS_F3); float* TWp = (float*)(ws + WS_TW);
          for (int i = gt; i < 32768; i += NGT) { const int rt = i >> 7, Kc = i & 127; float v1 = 0.f, v3 = 0.f;
              if (rt < 128) { const int m_ = (rt >> 4) & 3, ri = m_ & 1, k1 = 32 * (rt >> 6) + 16 * (m_ >> 1) + (rt & 15), part = Kc >> 6, s1 = Kc & 63; const float x = (float)((k1 * s1) & 63) * (1.0f / 32.0f);
                  const float cv = cospif(x), sv = sinpif(x); v1 = ri == 0 ? (part == 0 ? cv : -sv) : (part == 0 ? sv : cv); }
              if (rt < 64) { const int ri = Kc >> 6, s2 = Kc & 63; const float x = (float)((rt * s2) & 63) * (1.0f / 32.0f); v3 = (ri == 0 ? cospif(x) : -sinpif(x)) * (1.0f / 64.0f); }
              F1[i] = (bf16)f2bf(v1); F3[i] = (bf16)f2bf(v3); }
          for (int i = gt; i < 4096; i += NGT) { const int k1 = i >> 6, s2 = i & 63; const float x = (float)(k1 * s2) * (1.0f / 2048.0f); TWp[2 * i] = cospif(x); TWp[2 * i + 1] = sinpif(x); } }
    }
    PH_END(0)
    if (G == 0x7fffffff) grid.sync();
    xcd_barrier(xbar);

    PH_BEGIN(1)
#ifndef NO_G1A
    { pg8::Gemm g{XN, W1t, MTOK, 4096, 1024}; pg8::StaticOrder S; S.init(MTOK, 4096, G, bid);
      pg8::EpiQKG E{Qb, Kb, Gt, b_bg, 0.125f * LOG2E};
      pg8::gemm_phase<pg8::EpiQKG, pg8::StaticOrder, true, true>(lds, g, S, E); }
#endif
#ifndef NO_G1B
    { pg8::Gemm g{W2t, XNp, 1024, MTOK, 1024}; pg8::StaticOrder S; S.init(1024, MTOK, G, bid);
      pg8::EpiZ4 E{ZT};
      pg8::gemm_phase<pg8::EpiZ4, pg8::StaticOrder, true, true>(lds, g, S, E); }
    { pg8::Gemm g{W2t + (size_t)1024 * 1024, XN, 1024, MTOK, 1024}; pg8::StaticOrder S; S.init(1024, MTOK, G, bid);
      pg8::EpiVT E{VT};
      pg8::gemm_phase<pg8::EpiVT, pg8::StaticOrder, true, true>(lds, g, S, E); }
#endif
    PH_END(1)
    xcd_barrier(xbar);
#if PROBE_PHASE == 99
    PH_BEGIN(99)
    grid.sync();
    PH_END(99)
#endif

    PH_BEGIN(20)
#ifndef NO_G2
    { int k128 = 128; asm volatile("" : "+s"(k128));
      { pg8::Gemm g{(const bf16*)(ws + WS_F1), ZT, 256, 327680, k128}; pg8::StaticOrder S; S.init(256, 327680, G, bid);
        pg8::EpiG E{(const float*)(ws + WS_TW), (bf16*)(ws + WS_XN), (bf16*)(ws + WS_DM)};
        pg8::gemm_phase<pg8::EpiG, pg8::StaticOrder, true, true>(lds, g, S, E); }
      xcd_barrier(xbar);
      { pg8::Gemm g{(const bf16*)(ws + WS_F3), (const bf16*)(ws + WS_XN), 256, 163840, k128}; pg8::StaticOrder S; S.init(256, 163840, G, bid);
        pg8::EpiY3 E{Yb, 0};
        pg8::gemm_phase<pg8::EpiY3, pg8::StaticOrder, true, true>(lds, g, S, E); }
      { pg8::Gemm g{(const bf16*)(ws + WS_F3), (const bf16*)(ws + WS_DM), 256, 163840, k128}; pg8::StaticOrder S; S.init(256, 163840, G, (bid + (G >> 1)) % G);
        pg8::EpiY3 E{Yb, 4};
        pg8::gemm_phase<pg8::EpiY3, pg8::StaticOrder, true, true>(lds, g, S, E); } }
#endif
    PH_END(20)
    PH_BEGIN(21)
    {
        const float d1 = wave_sum(lq1[lane] * lk1[lane]), d2 = wave_sum(lq2[lane] * lk2[lane]);
        const float lam = __expf(d1) - __expf(d2) + 0.2f;
        for (int u = bid; u < 2048; u += G) { const int xcd = u & 7, w = u >> 3, bh = xcd * 8 + (w >> 5), qb = ((w >> 5) & 1) ? ((w + 16) & 31) : (w & 31);
#ifndef NO_ATT
            da::attn_unit(lds, bh >> 3, bh & 7, qb, Qb, Kb, VT, Ob, lam, g_subln, (const float*)(ws + WS_QN2), (const float*)(ws + WS_KN2));
#endif
        }
    }
    PH_END(21)
    xcd_barrier(xbar);

    PH_BEGIN(3)
#ifndef NO_G3A
    { pg8::Gemm g{Yb, Wft, MTOK, 1024, 1024}; pg8::StaticOrder S; S.init(MTOK, 1024, G, bid);
      pg8::EpiGateF E{Gt, T32};
      pg8::gemm_phase<pg8::EpiGateF, pg8::StaticOrder, true, true>(lds, g, S, E); }
#endif
#ifndef NO_G3B
    { pg8::Gemm g{Ob, Wat, MTOK, 1024, 1024}; pg8::StaticOrder S; S.init(MTOK, 1024, G, bid);
      pg8::EpiGateA E{Gt, T32, MG};
      pg8::gemm_phase<pg8::EpiGateA, pg8::StaticOrder, true, true>(lds, g, S, E); }
#endif
    PH_END(3)
    xcd_barrier(xbar);

    PH_BEGIN(4)
#ifndef NO_G4A
    { pg8::Gemm g{MG, Wot, MTOK, 1024, 1024}; pg8::StaticOrder S; S.init(MTOK, 1024, G, bid);
      pg8::EpiResid<false> E{xin, X1b, ss1};
      pg8::gemm_phase<pg8::EpiResid<false>, pg8::StaticOrder, true, true>(lds, g, S, E); }
#endif
#ifndef NO_G4B
    { int kpp = 256; asm volatile("" : "+s"(kpp)); pg8::Gemm g{Pb, Wppt, MTOK, 1024, kpp}; pg8::StaticOrder S; S.init(MTOK, 1024, G, bid);
      pg8::EpiPlain E{PP, 1024};
      pg8::gemm_phase<pg8::EpiPlain, pg8::StaticOrder, true, true>(lds, g, S, E); }
#endif
    PH_END(4)
    xcd_barrier(xbar);

    PH_BEGIN(5)
#ifndef NO_G5
    { pg8::Gemm g{X1b, Wgut, MTOK, 2 * DFF, 1024}; pg8::StaticOrder S; S.init(MTOK, 2 * DFF, G, bid);
      pg8::EpiSwiGLU E{ss1, Hb};
      pg8::gemm_phase<pg8::EpiSwiGLU, pg8::StaticOrder, true, true>(lds, g, S, E); }
#endif
    PH_END(5)
    xcd_barrier(xbar);

    PH_BEGIN(6)
#ifndef NO_G6
    { pg8::Gemm g{Hb, Wdt, MTOK, 1024, DFF}; pg8::StaticOrder S; S.init(MTOK, 1024, G, bid);
      pg8::EpiResid<true> E{X1b, X1b, ss2};
      pg8::gemm_phase<pg8::EpiResid<true>, pg8::StaticOrder, true, true>(lds, g, S, E); }
#endif
    PH_END(6)
    xcd_barrier(xbar);

    PH_BEGIN(7)
#ifndef NO_G7
    { pg8::Gemm g{X1b, Wpgt, MTOK, 1024, 1024}; pg8::StaticOrder S; S.init(MTOK, 1024, G, bid);
      pg8::EpiPle E{ss2, PP, X1b, Qb, ss3};
      pg8::gemm_phase<pg8::EpiPle, pg8::StaticOrder, true, true>(lds, g, S, E); }
#endif
    PH_END(7)
    xcd_barrier(xbar);

    for (int m = gw; m < MTOK; m += NGW) {
        f32x4* xr = (f32x4*)(out + (size_t)m * DM) + lane; const v2u* xb = (const v2u*)(Qb + (size_t)m * DM) + lane;
        const float rstd = __builtin_amdgcn_rsqf(ss3[m] * (1.0f / 1024.0f) + 1e-6f);
#pragma unroll
        for (int j = 0; j < 4; ++j) { const f32x4 g = ((const f32x4*)g_final)[lane + 64 * j]; const v2u w = __builtin_nontemporal_load(&xb[64 * j]);
            const f32x4 v = {__uint_as_float(w.x << 16), __uint_as_float(w.x & 0xffff0000u), __uint_as_float(w.y << 16), __uint_as_float(w.y & 0xffff0000u)};
            __builtin_nontemporal_store(v * rstd * g, &xr[64 * j]); }
    }
}

#undef xin
#undef pin
#undef g_mix
#undef w_in
#undef lq1
#undef lk1
#undef lq2
#undef lk2
#undef g_subln
#undef w_fo
#undef w_ao
#undef w_bg
#undef b_bg
#undef w_o
#undef g_ffn
#undef w_fg
#undef w_fu
#undef w_fd
#undef g_ple
#undef w_pg
#undef w_pp
#undef g_final
#undef out
#undef ws
#undef ss1
#undef ss2
#undef ss3
#undef W1t
#undef W2t
#undef Wft
#undef Wat
#undef Wot
#undef Wgut
#undef Wdt
#undef Wpgt
#undef Wppt
#undef Pb
#undef XN
#undef Yb
#undef X1b
#undef Qb
#undef Ob
#undef Kb
#undef MG
#undef VT
#undef PP
#undef ZT
#undef Hb
#undef XNp
#undef Gt
#undef T32
#undef KIN
extern "C" void kernel_launch(void* const* d_in, const int* in_sizes, int n_in, void* d_out, int out_size, void* d_ws, size_t ws_size, hipStream_t stream) {
    static int grid = 0;
    if (grid == 0) {
        if (n_in != 22 || in_sizes[0] != MTOK * DM || out_size != MTOK * DM || ws_size < WS_END) { fprintf(stderr, "kernel_launch: unexpected shapes / workspace (n_in %d, ws %zu)\n", n_in, ws_size); grid = -1; return; }
        int dev = 0, cus = 0, per_cu = 0;
        if (hipGetDevice(&dev) != hipSuccess || hipDeviceGetAttribute(&cus, hipDeviceAttributeMultiprocessorCount, dev) != hipSuccess) { grid = -1; return; }
        if (hipFuncSetAttribute((const void*)fwd_megakernel, hipFuncAttributeMaxDynamicSharedMemorySize, LDS_BYTES) != hipSuccess) { fprintf(stderr, "kernel_launch: hipFuncSetAttribute failed\n"); grid = -1; return; }
        if (hipOccupancyMaxActiveBlocksPerMultiprocessor(&per_cu, (const void*)fwd_megakernel, 512, LDS_BYTES) != hipSuccess || per_cu < 1) { fprintf(stderr, "kernel_launch: occupancy query failed (%d)\n", per_cu); (void)hipGetLastError(); per_cu = 1; }
        grid = cus * per_cu;
    }
    if (grid < 0) return;
    (void)hipMemsetAsync((char*)d_ws + WS_CTL, 0, CTL_ZERO_BYTES, stream);
    (void)hipMemsetAsync((char*)d_ws + WS_QN2, 0, NRM_ZERO_BYTES, stream);
    Args a{};
    for (int i = 0; i < 22; ++i) a.in[i] = (const float*)d_in[i];
    a.out = (float*)d_out; a.ws = (unsigned char*)d_ws;
    void* args[] = {&a};
    hipError_t e = hipLaunchCooperativeKernel((const void*)fwd_megakernel, dim3(grid), dim3(512), args, LDS_BYTES, stream);
    if (e != hipSuccess) fprintf(stderr, "cooperative launch failed: %s (grid %d)\n", hipGetErrorString(e), grid);
}
```
